# Optimizing an MI355X kernel written in HIP

```python
import math
import jax, jax.numpy as jnp
from jax import lax
import numpy as np

D_MODEL = 1024
BATCH = 16
SEQ = 4096
DEPTH = 4

N_MIXERS = 4
N_A = (DEPTH + 3) // 4
N_B = (DEPTH + 2) // 4
N_C = (DEPTH + 1) // 4
N_D = DEPTH // 4
A_HEADS = 4
A_DV = D_MODEL // A_HEADS
A_DK = A_DV // 2
A_CHUNK = 64
A_IN = 2 * A_HEADS * A_DK + 2 * A_HEADS * A_DV + 2 * A_HEADS
B_HEAD_DIM = 64
B_Q_HEADS = D_MODEL // B_HEAD_DIM
B_KV_HEADS = B_Q_HEADS // 8
B_WINDOW = 128
B_BLOCK = 128
B_IN = (B_Q_HEADS + 2 * B_KV_HEADS) * B_HEAD_DIM
C_EXPAND = 128
C_HEADS = D_MODEL // C_EXPAND
C_DK = C_EXPAND
C_DV = D_MODEL // C_HEADS
C_CHUNK = 16
C_IN = 2 * C_HEADS * C_DK + 2 * C_HEADS * C_DV
D_HEAD_DIM = 64
D_HEADS = D_MODEL // (2 * D_HEAD_DIM)
D_QBLOCK = 128
D_IN = 3 * D_HEADS * 2 * D_HEAD_DIM
ROPE_THETA = 500000.0
ROT_FRAC = 4
FFN_HIDDEN = -(-8 * D_MODEL // (3 * 256)) * 256
DEEPNORM_ALPHA = (2 * DEPTH) ** 0.25
DEEPNORM_BETA = (8 * DEPTH) ** -0.25
F32 = jnp.float32

kernel_name = "hybrid_interleaved_mlstm_swa_hgrn2_diffattn"


def layer_norm(x, g, b, eps=1e-5):
    xf = x.astype(F32)
    mu = xf.mean(-1, keepdims=True)
    var = jnp.square(xf - mu).mean(-1, keepdims=True)
    return ((xf - mu) * lax.rsqrt(var + eps) * g.astype(F32) + b.astype(F32)).astype(x.dtype)


def head_rms_norm(h, w, eps=1e-6):
    hf = h.astype(F32)
    return hf * lax.rsqrt(jnp.mean(hf * hf, -1, keepdims=True) + eps) * w.astype(F32)


def partial_rope(x, positions):
    hd = x.shape[-1]
    rot = hd // ROT_FRAC
    half = rot // 2
    inv = jnp.power(ROPE_THETA, -jnp.arange(half, dtype=F32) * 2.0 / rot)
    ang = positions.astype(F32)[..., None] * inv
    cos = jnp.cos(ang)[:, :, None, :]
    sin = jnp.sin(ang)[:, :, None, :]
    xf = x.astype(F32)
    x1, x2 = xf[..., :half], xf[..., half:rot]
    out = jnp.concatenate([x1 * cos - x2 * sin, x2 * cos + x1 * sin, xf[..., rot:]], axis=-1)
    return out.astype(x.dtype)


def to_chunks(a, L):
    r = a.reshape(a.shape[0], a.shape[1] // L, L, *a.shape[2:])
    return jnp.swapaxes(jnp.moveaxis(r, 1, 0), 2, 3)


def from_chunks(a):
    r = jnp.moveaxis(jnp.swapaxes(a, 2, 3), 0, 1)
    return r.reshape(r.shape[0], r.shape[1] * r.shape[2], *r.shape[3:])


def mlstm_mixer(h, w_in, b_gate, norm_w, w_out):
    bsz, seq, _ = h.shape
    qk, vw = A_HEADS * A_DK, A_HEADS * A_DV
    proj = (h @ w_in).astype(F32)
    q = proj[..., :qk].reshape(bsz, seq, A_HEADS, A_DK)
    k = proj[..., qk:2 * qk].reshape(bsz, seq, A_HEADS, A_DK) * (A_DK ** -0.5)
    v = proj[..., 2 * qk:2 * qk + vw].reshape(bsz, seq, A_HEADS, A_DV)
    o = jax.nn.sigmoid(proj[..., 2 * qk + vw:2 * qk + 2 * vw]).reshape(bsz, seq, A_HEADS, A_DV)
    gates = proj[..., 2 * qk + 2 * vw:] + b_gate.astype(F32)
    i_pre = gates[..., :A_HEADS]
    log_f = jax.nn.log_sigmoid(gates[..., A_HEADS:])
    causal = jnp.tril(jnp.ones((A_CHUNK, A_CHUNK), bool))

    def step(carry, xs):
        C, n, m = carry
        qc, kc, vc, ic, fc = xs
        b = jnp.cumsum(fc, axis=-1)
        dmat = jnp.where(causal, b[..., :, None] - b[..., None, :] + ic[..., None, :], -jnp.inf)
        m_inter = b + m[..., None]
        m_t = jnp.maximum(m_inter, dmat.max(-1))
        a = jnp.einsum('bhtd,bhsd->bhts', qc, kc) * jnp.exp(dmat - m_t[..., None])
        w_inter = jnp.exp(m_inter - m_t)
        num = jnp.einsum('bhts,bhse->bhte', a, vc) + w_inter[..., None] * jnp.einsum('bhtd,bhde->bhte', qc, C)
        den = a.sum(-1) + w_inter * jnp.einsum('bhtd,bhd->bht', qc, n)
        h_out = num / jnp.maximum(jnp.abs(den), jnp.exp(-m_t))[..., None]
        b_last = b[..., -1]
        g = b_last[..., None] - b + ic
        m_new = jnp.maximum(b_last + m, g.max(-1))
        decay = jnp.exp(b_last + m - m_new)
        ws = jnp.exp(g - m_new[..., None])
        C_new = decay[..., None, None] * C + jnp.einsum('bhs,bhsd,bhse->bhde', ws, kc, vc)
        n_new = decay[..., None] * n + jnp.einsum('bhs,bhsd->bhd', ws, kc)
        return (C_new, n_new, m_new), h_out

    init = (jnp.zeros((bsz, A_HEADS, A_DK, A_DV), F32),
            jnp.zeros((bsz, A_HEADS, A_DK), F32),
            jnp.zeros((bsz, A_HEADS), F32))
    xs = (to_chunks(q, A_CHUNK), to_chunks(k, A_CHUNK), to_chunks(v, A_CHUNK),
          to_chunks(i_pre, A_CHUNK), to_chunks(log_f, A_CHUNK))
    _, ys = lax.scan(step, init, xs)
    hs = from_chunks(ys)
    y = head_rms_norm(hs, norm_w.reshape(A_HEADS, A_DV)) * o
    return y.reshape(bsz, seq, vw).astype(w_out.dtype) @ w_out


def swa_mixer(h, positions, w_in, sinks, w_out):
    bsz, seq, _ = h.shape
    nb = seq // B_BLOCK
    grp = B_Q_HEADS // B_KV_HEADS
    qw, kw = B_Q_HEADS * B_HEAD_DIM, B_KV_HEADS * B_HEAD_DIM
    proj = h @ w_in
    q = partial_rope(proj[..., :qw].reshape(bsz, seq, B_Q_HEADS, B_HEAD_DIM), positions)
    k = partial_rope(proj[..., qw:qw + kw].reshape(bsz, seq, B_KV_HEADS, B_HEAD_DIM), positions)
    v = proj[..., qw + kw:].reshape(bsz, seq, B_KV_HEADS, B_HEAD_DIM)
    qb = jnp.moveaxis(q.reshape(bsz, nb, B_BLOCK, B_KV_HEADS, grp, B_HEAD_DIM), 1, 0)

    def band(a):
        ap = jnp.pad(a, ((0, 0), (B_BLOCK, 0), (0, 0), (0, 0)))
        ap = ap.reshape(bsz, nb + 1, B_BLOCK, B_KV_HEADS, B_HEAD_DIM)
        return jnp.moveaxis(jnp.concatenate([ap[:, :-1], ap[:, 1:]], axis=2), 1, 0)

    kb, vb = band(k), band(v)
    sink = sinks.astype(F32).reshape(1, B_KV_HEADS, grp, 1, 1)
    scale = B_HEAD_DIM ** -0.5

    def block(args):
        qi, ki, vi, n = args
        s = jnp.einsum('bqhgd,bkhd->bhgqk', qi, ki, preferred_element_type=F32) * scale
        qpos = n * B_BLOCK + jnp.arange(B_BLOCK)
        kpos = (n - 1) * B_BLOCK + jnp.arange(2 * B_BLOCK)
        rel = qpos[:, None] - kpos[None, :]
        valid = (rel >= 0) & (rel < B_WINDOW) & (kpos >= 0)[None, :]
        s = jnp.where(valid, s, -jnp.inf)
        mx = jnp.maximum(s.max(-1, keepdims=True), sink)
        p = jnp.exp(s - mx)
        p = p / (p.sum(-1, keepdims=True) + jnp.exp(sink - mx))
        return jnp.einsum('bhgqk,bkhd->bqhgd', p, vi.astype(F32))

    out = lax.map(block, (qb, kb, vb, jnp.arange(nb)))
    out = jnp.moveaxis(out, 0, 1).reshape(bsz, seq, qw)
    return out.astype(w_out.dtype) @ w_out


def hgrn2_mixer(h, lower_bound, w_in, norm_w, w_out):
    bsz, seq, _ = h.shape
    kw, vw = C_HEADS * C_DK, C_HEADS * C_DV
    proj = (h @ w_in).astype(F32)
    q = proj[..., :kw]
    f_pre = proj[..., kw:2 * kw]
    i_in = proj[..., 2 * kw:2 * kw + vw]
    g_out = proj[..., 2 * kw + vw:]
    lb = lower_bound.astype(F32)
    log_f = jnp.logaddexp(jnp.log(lb), jnp.log1p(-lb) + jax.nn.log_sigmoid(f_pre))
    k = (1.0 - lb) * jax.nn.sigmoid(-f_pre)
    heads = lambda a, d: a.reshape(bsz, seq, C_HEADS, d)
    causal = jnp.tril(jnp.ones((C_CHUNK, C_CHUNK), bool))[:, :, None]

    def step(S, xs):
        qc, kc, vc, fc = xs
        cf = jnp.cumsum(fc, axis=2)
        diff = cf[:, :, :, None, :] - cf[:, :, None, :, :]
        decay = jnp.exp(jnp.where(causal, diff, -jnp.inf))
        a = jnp.einsum('bhtd,bhtsd,bhsd->bhts', qc, decay, kc)
        o = jnp.einsum('bhts,bhse->bhte', a, vc) + jnp.einsum('bhtd,bhde->bhte', qc * jnp.exp(cf), S)
        last = cf[:, :, -1:, :]
        S_new = jnp.exp(last[:, :, 0, :])[..., None] * S + jnp.einsum('bhsd,bhse->bhde', kc * jnp.exp(last - cf), vc)
        return S_new, o

    xs = (to_chunks(heads(q, C_DK), C_CHUNK), to_chunks(heads(k, C_DK), C_CHUNK),
          to_chunks(heads(i_in, C_DV), C_CHUNK), to_chunks(heads(log_f, C_DK), C_CHUNK))
    _, ys = lax.scan(step, jnp.zeros((bsz, C_HEADS, C_DK, C_DV), F32), xs)
    o = from_chunks(ys)
    y = head_rms_norm(o, norm_w.reshape(C_HEADS, C_DV)) * jax.nn.silu(heads(g_out, C_DV))
    return y.reshape(bsz, seq, vw).astype(w_out.dtype) @ w_out


def diff_mixer(h, positions, lam_init, w_in, lam_vec, norm_w, w_out):
    bsz, seq, _ = h.shape
    nb = seq // D_QBLOCK
    w = D_HEADS * 2 * D_HEAD_DIM
    proj = h @ w_in
    q = partial_rope(proj[..., :w].reshape(bsz, seq, 2 * D_HEADS, D_HEAD_DIM), positions)
    k = partial_rope(proj[..., w:2 * w].reshape(bsz, seq, 2 * D_HEADS, D_HEAD_DIM), positions)
    q = q.reshape(bsz, seq, D_HEADS, 2, D_HEAD_DIM)
    k = k.reshape(bsz, seq, D_HEADS, 2, D_HEAD_DIM)
    v = proj[..., 2 * w:].reshape(bsz, seq, D_HEADS, 2 * D_HEAD_DIM).astype(F32)
    lv = lam_vec.astype(F32)
    lam = jnp.exp(jnp.sum(lv[0] * lv[1])) - jnp.exp(jnp.sum(lv[2] * lv[3])) + lam_init
    qb = jnp.moveaxis(q.reshape(bsz, nb, D_QBLOCK, D_HEADS, 2, D_HEAD_DIM), 1, 0)
    kpos = jnp.arange(seq)
    scale = D_HEAD_DIM ** -0.5

    def block(args):
        qi, n = args
        s = jnp.einsum('bqhcd,bkhcd->bhcqk', qi, k, preferred_element_type=F32) * scale
        qpos = n * D_QBLOCK + jnp.arange(D_QBLOCK)
        s = jnp.where(kpos[None, :] <= qpos[:, None], s, -jnp.inf)
        p = jax.nn.softmax(s, axis=-1)
        a = p[:, :, 0] - lam * p[:, :, 1]
        return jnp.einsum('bhqk,bkhe->bqhe', a, v)

    out = lax.map(block, (qb, jnp.arange(nb)))
    out = jnp.moveaxis(out, 0, 1).reshape(bsz, seq, D_HEADS, 2 * D_HEAD_DIM)
    out = head_rms_norm(out, norm_w) * (1.0 - lam_init)
    return out.reshape(bsz, seq, w).astype(w_out.dtype) @ w_out


def swiglu(h, w_in, w_out):
    gu = h @ w_in
    return (jax.nn.silu(gu[..., :FFN_HIDDEN]) * gu[..., FFN_HIDDEN:]) @ w_out


def setup_inputs(seed: int = 0) -> dict:
    key = jax.random.key(seed)
    ks = jax.random.split(key, 26)
    nrm = lambda k, shape, s: jax.random.normal(k, shape, F32) * s
    D = D_MODEL
    beta = DEEPNORM_BETA
    x = nrm(ks[0], (BATCH, SEQ, D), 1.0)
    c = nrm(ks[1], (BATCH, D), 1.0)
    positions = jnp.broadcast_to(jnp.arange(SEQ, dtype=jnp.int32), (BATCH, SEQ))
    ada_w = nrm(ks[2], (DEPTH, 2, D, 3 * D), 0.1 * D ** -0.5)
    ada_b = nrm(ks[3], (DEPTH, 2, 3 * D), 0.01)
    ln_g = 1.0 + nrm(ks[4], (DEPTH, 2, D), 0.02)
    ln_b = nrm(ks[5], (DEPTH, 2, D), 0.01)
    mlstm_w_in = nrm(ks[6], (N_A, D, A_IN), D ** -0.5)
    mlstm_b_gate = jnp.concatenate(
        [nrm(ks[7], (N_A, A_HEADS), 0.1),
         jnp.linspace(3.0, 6.0, A_HEADS, dtype=F32) + nrm(ks[8], (N_A, A_HEADS), 0.1)], axis=-1)
    mlstm_norm = 1.0 + nrm(ks[9], (N_A, A_HEADS * A_DV), 0.02)
    mlstm_w_out = nrm(ks[10], (N_A, A_HEADS * A_DV, D), beta * (A_HEADS * A_DV) ** -0.5)
    swa_w_in = nrm(ks[11], (N_B, D, B_IN), D ** -0.5)
    swa_sinks = nrm(ks[12], (N_B, B_Q_HEADS), 0.5)
    swa_w_out = nrm(ks[13], (N_B, B_Q_HEADS * B_HEAD_DIM, D), beta * (B_Q_HEADS * B_HEAD_DIM) ** -0.5)
    hgrn_w_in = nrm(ks[14], (N_C, D, C_IN), D ** -0.5)
    hgrn_lower_bounds = nrm(ks[15], (DEPTH, C_HEADS * C_DK), 0.1)
    hgrn_norm = 1.0 + nrm(ks[16], (N_C, C_HEADS * C_DV), 0.02)
    hgrn_w_out = nrm(ks[17], (N_C, C_HEADS * C_DV, D), beta * (C_HEADS * C_DV) ** -0.5)
    diff_w_in = nrm(ks[18], (N_D, D, D_IN), D ** -0.5)
    diff_lambda = nrm(ks[19], (N_D, 4, D_HEAD_DIM), 0.1)
    diff_norm = 1.0 + nrm(ks[20], (N_D, 2 * D_HEAD_DIM), 0.02)
    diff_w_out = nrm(ks[21], (N_D, D_HEADS * 2 * D_HEAD_DIM, D), beta * (D_HEADS * 2 * D_HEAD_DIM) ** -0.5)
    ffn_w_in = nrm(ks[22], (DEPTH, D, 2 * FFN_HIDDEN), D ** -0.5)
    ffn_w_out = nrm(ks[23], (DEPTH, FFN_HIDDEN, D), beta * FFN_HIDDEN ** -0.5)
    return {"x": x, "c": c, "positions": positions, "ada_w": ada_w, "ada_b": ada_b,
            "ln_g": ln_g, "ln_b": ln_b,
            "mlstm_w_in": mlstm_w_in, "mlstm_b_gate": mlstm_b_gate, "mlstm_norm": mlstm_norm,
            "mlstm_w_out": mlstm_w_out,
            "swa_w_in": swa_w_in, "swa_sinks": swa_sinks, "swa_w_out": swa_w_out,
            "hgrn_w_in": hgrn_w_in, "hgrn_lower_bounds": hgrn_lower_bounds, "hgrn_norm": hgrn_norm,
            "hgrn_w_out": hgrn_w_out,
            "diff_w_in": diff_w_in, "diff_lambda": diff_lambda, "diff_norm": diff_norm,
            "diff_w_out": diff_w_out,
            "ffn_w_in": ffn_w_in, "ffn_w_out": ffn_w_out}


def reference(x, c, positions, ada_w, ada_b, ln_g, ln_b,
              mlstm_w_in, mlstm_b_gate, mlstm_norm, mlstm_w_out,
              swa_w_in, swa_sinks, swa_w_out,
              hgrn_w_in, hgrn_lower_bounds, hgrn_norm, hgrn_w_out,
              diff_w_in, diff_lambda, diff_norm, diff_w_out,
              ffn_w_in, ffn_w_out):
    cond = jax.nn.silu(c.astype(F32))
    lbs = jnp.cumsum(jax.nn.softmax(hgrn_lower_bounds.astype(F32), axis=0), axis=0)
    lbs = lbs - lbs[0]
    for i in range(DEPTH):
        mixer, j = i % N_MIXERS, i // N_MIXERS
        mod = jnp.einsum('bd,sde->sbe', cond, ada_w[i].astype(F32)) + ada_b[i][:, None, :].astype(F32)
        shift, scale, gate = jnp.split(mod.astype(x.dtype), 3, axis=-1)
        h = x * (1 + scale[0][:, None]) + shift[0][:, None]
        if mixer == 0:
            y = mlstm_mixer(h, mlstm_w_in[j], mlstm_b_gate[j], mlstm_norm[j], mlstm_w_out[j])
        elif mixer == 1:
            y = swa_mixer(h, positions, swa_w_in[j], swa_sinks[j], swa_w_out[j])
        elif mixer == 2:
            y = hgrn2_mixer(h, lbs[i], hgrn_w_in[j], hgrn_norm[j], hgrn_w_out[j])
        else:
            lam_init = 0.8 - 0.6 * math.exp(-0.3 * i)
            y = diff_mixer(h, positions, lam_init, diff_w_in[j], diff_lambda[j], diff_norm[j], diff_w_out[j])
        x = layer_norm(DEEPNORM_ALPHA * x + (1 + gate[0][:, None]) * y.astype(x.dtype), ln_g[i, 0], ln_b[i, 0])
        h = x * (1 + scale[1][:, None]) + shift[1][:, None]
        y = swiglu(h, ffn_w_in[i], ffn_w_out[i])
        x = layer_norm(DEEPNORM_ALPHA * x + (1 + gate[1][:, None]) * y.astype(x.dtype), ln_g[i, 1], ln_b[i, 1])
    return x
```

```cpp
#include <hip/hip_runtime.h>
#include <hip/hip_cooperative_groups.h>
#include <cstdio>
#include <cstdint>
namespace cg = cooperative_groups;
__device__ __forceinline__ int otid() { int t = threadIdx.x; asm volatile("" : "+v"(t)); return t; }
__device__ __forceinline__ void lds_barrier() { asm volatile("s_waitcnt lgkmcnt(0)\n\ts_barrier" ::: "memory"); }
#define GAS __attribute__((address_space(1)))
#define LAS __attribute__((address_space(3)))
#define XB_TMO      128
#define XB_XCNT(j)  (256  + 64 * (j))
#define XB_XSUB(j)  (1280 + 64 * (j))
#define XB_XGEN(j)  (2304 + 64 * (j))
#define XB_TOP      3328
#define XB_TOPGEN   3392
#define XCD_BAR_WORDS 3456
#define XB_SPIN_CAP (1u << 22)

__device__ __forceinline__ unsigned xb_ld(unsigned* p)              { return __hip_atomic_load(p, __ATOMIC_RELAXED, __HIP_MEMORY_SCOPE_AGENT); }
__device__ __forceinline__ unsigned xb_add(unsigned* p, unsigned v) { return __hip_atomic_fetch_add(p, v, __ATOMIC_RELAXED, __HIP_MEMORY_SCOPE_AGENT); }
__device__ __forceinline__ unsigned xb_xcc_id() { return (unsigned)__builtin_amdgcn_s_getreg((3 << 11) | 20) & 0xFu; }
#define XB_SPIN(cond, bar) do { unsigned _sp = 0; while (cond) { __builtin_amdgcn_s_sleep(1); \
    if ((++_sp & 255u) == 0u) { if (xb_ld(&(bar)[XB_TMO])) break; if (_sp > XB_SPIN_CAP) { atomicAdd(&(bar)[XB_TMO], 1u); break; } } } } while (0)

struct XcdBarrier {
    unsigned* bar; unsigned x;
    volatile LAS unsigned* st;
};

__device__ __forceinline__ XcdBarrier xcd_barrier_post(unsigned* bar, volatile LAS unsigned* st) {
    XcdBarrier b; b.bar = bar; b.x = xb_xcc_id(); b.st = st;
    if (threadIdx.x == 0) (void)xb_add(&bar[XB_XCNT(b.x)], 1u);
    return b;
}
__device__ __forceinline__ void xcd_barrier_complete(unsigned* bar, unsigned x, unsigned& nloc, unsigned& nx) {
    const unsigned G = gridDim.x * gridDim.y * gridDim.z;
    unsigned sum, cnt, mine, sp = 0u;
    for (;;) {
        sum = 0u; cnt = 0u; mine = 0u;
#pragma unroll
        for (unsigned j = 0; j < 16; ++j) { const unsigned c = xb_ld(&bar[XB_XCNT(j)]); sum += c; cnt += (c > 0u) ? 1u : 0u; mine = (j == x) ? c : mine; }
        if (sum == G) break;
        __builtin_amdgcn_s_sleep(1);
        if ((++sp & 255u) == 0u) { if (xb_ld(&bar[XB_TMO])) break; if (sp > XB_SPIN_CAP) { atomicAdd(&bar[XB_TMO], 1u); break; } }
    }
    nloc = mine > 0u ? mine : 1u; nx = cnt > 0u ? cnt : 1u;
}

__device__ __forceinline__ void xcd_barrier(const XcdBarrier& b) {
    asm volatile("s_waitcnt vmcnt(0)" ::: "memory");
    __syncthreads();
    if (threadIdx.x == 0) {
        unsigned* bar = b.bar;
        __builtin_amdgcn_s_waitcnt(0);
        unsigned nloc = b.st[0], nx = b.st[1];
        if (nloc == 0u) { xcd_barrier_complete(bar, b.x, nloc, nx); b.st[0] = nloc; b.st[1] = nx; }
        const unsigned old = xb_add(&bar[XB_XSUB(b.x)], 1u);
        const unsigned gen = old / nloc;
        if (old + 1u == (gen + 1u) * nloc) {
            __builtin_amdgcn_fence(__ATOMIC_RELEASE, "agent");
            asm volatile("s_waitcnt vmcnt(0)" ::: "memory");
            const unsigned og = xb_add(&bar[XB_TOP], 1u);
            const unsigned tg = og / nx;
            if (og + 1u == (tg + 1u) * nx) xb_add(&bar[XB_TOPGEN], 1u);
            else XB_SPIN(xb_ld(&bar[XB_TOPGEN]) == tg, bar);
            __builtin_amdgcn_fence(__ATOMIC_ACQUIRE, "agent");
            xb_add(&bar[XB_XGEN(b.x)], 1u);
            asm volatile("s_waitcnt vmcnt(0)" ::: "memory");
        } else {
            XB_SPIN(xb_ld(&bar[XB_XGEN(b.x)]) == gen, bar);
            __builtin_amdgcn_fence(__ATOMIC_ACQUIRE, "agent");
            asm volatile("s_waitcnt vmcnt(0)" ::: "memory");
        }
    }
    __syncthreads();
}
namespace pg8 {
#define PG8_LAS __attribute__((address_space(3)))
typedef unsigned short bf16_t;
typedef short bf16x8 __attribute__((ext_vector_type(8)));
typedef float f32x4 __attribute__((ext_vector_type(4)));
typedef unsigned u32x4 __attribute__((ext_vector_type(4)));
constexpr int BM = 256, BK = 64, HALF = 128, HTB = HALF * BK * 2  , STAGE_BYTES = 8 * HTB, NXCD = 8, WGM = 8;

__host__ __device__ __forceinline__ int lds_byte(int r, int c) { const int st = (r >> 4) * 2 + (c >> 5), rr = r & 15, cc = c & 31, ob = rr * 64 + cc * 2; return st * 1024 + (ob ^ (((ob >> 9) & 1) << 5)); }
__host__ __device__ __forceinline__ void stage_rc(int b, int& R, int& C) { const int st = b / 1024, sb = b % 1024, swz = sb ^ (((sb >> 9) & 1) << 5); R = (st >> 1) * 16 + swz / 64; C = (st & 1) * 32 + (swz % 64) / 2; }
__host__ __device__ __forceinline__ int perm32(int rho) { const int n = rho >> 4, i = rho & 15; return 8 * (i >> 2) + 4 * n + (i & 3); }

struct Unit { int pm, pn; };
struct Gemm { const bf16_t* A; const bf16_t* Bt; int M, N, K; };

struct StaticOrder {
    int nM, nN, nwg, G, c;
    __host__ __device__ void init(int M, int N, int G_, int c_) { nM = M / BM; nN = N / BM; nwg = nM * nN; G = G_; c = c_; }
    __host__ __device__ bool next(int i, Unit& u) const {
        const long L = (long)i * G + c; if (L >= nwg) return false;
        int wgid = (int)L; { const int q = nwg / NXCD, r = nwg % NXCD, xcd = wgid % NXCD, off = wgid / NXCD; wgid = (xcd < r ? xcd * (q + 1) : r * (q + 1) + (xcd - r) * q) + off; }
        const int nig = WGM * nN, gid = wgid / nig, fm = gid * WGM, gsz = (nM - fm) < WGM ? (nM - fm) : WGM;
        u.pm = fm + ((wgid % nig) % gsz); u.pn = (wgid % nig) / gsz; return true;
    }
    __device__ __forceinline__ void a_ready(const Unit&) const {}
    __device__ __forceinline__ void done(const Unit&) const {}
};

typedef float f32x2_t __attribute__((ext_vector_type(2))); typedef __bf16 bf16x2_t __attribute__((ext_vector_type(2)));
__device__ __forceinline__ unsigned cvt_pk_bf16(float lo, float hi) { f32x2_t v = {lo, hi}; bf16x2_t b = __builtin_convertvector(v, bf16x2_t); return __builtin_bit_cast(unsigned, b); }
typedef unsigned u32x2 __attribute__((ext_vector_type(2)));
struct EpiProj {
    static constexpr bool PERM = true, AFTER_DRAIN = false;
    bf16_t* O; int ldc; int rope_cols; const float* rope; int qs_cols; float qs;
    __device__ __forceinline__ void operator()(const f32x4 (&acc)[2][2][4][2], const Unit& u, int wr, int wc, int fr, int fq) const {
        const int row0 = u.pm * BM + wr * 64 + fr, col0 = u.pn * BM + wc * 32 + 8 * fq;
#pragma unroll
        for (int ai = 0; ai < 2; ++ai)
#pragma unroll
            for (int m = 0; m < 4; ++m) { const int row = row0 + ai * HALF + m * 16; bf16_t* rowp = O + (size_t)row * ldc + col0;
#pragma unroll
                for (int bj = 0; bj < 2; ++bj) { const int col = col0 + bj * HALF; f32x4 v0 = acc[ai][bj][m][0], v1 = acc[ai][bj][m][1];
                    if (col < rope_cols && (col & 63) < 16) { const int j0 = (col & 8) >> 1; const f32x4* rt = (const f32x4*)(rope + (size_t)row * 16 + j0 * 2);
                        const f32x4 t0 = rt[0], t1 = rt[1]; const f32x4 cs = {t0[0], t0[2], t1[0], t1[2]}, sn = {t0[1], t0[3], t1[1], t1[3]};
                        const f32x4 n0 = v0 * cs - v1 * sn, n1 = v1 * cs + v0 * sn; v0 = n0; v1 = n1; }
                    if (col < qs_cols) { v0 = v0 * qs; v1 = v1 * qs; }
                    u32x4 w; w.x = cvt_pk_bf16(v0[0], v0[1]); w.y = cvt_pk_bf16(v0[2], v0[3]); w.z = cvt_pk_bf16(v1[0], v1[1]); w.w = cvt_pk_bf16(v1[2], v1[3]);
                    *(u32x4*)(rowp + bj * HALF) = w; } }
    }
};
__device__ __forceinline__ float silu_f(float g) { return g * __builtin_amdgcn_rcpf(1.0f + __expf(-g)); }
struct EpiSwiGLU {
    static constexpr bool PERM = true, AFTER_DRAIN = false;
    bf16_t* O; int ldc;
    __device__ __forceinline__ void operator()(const f32x4 (&acc)[2][2][4][2], const Unit& u, int wr, int wc, int fr, int fq) const {
        const int row0 = u.pm * BM + wr * 64 + fr, col0 = u.pn * HALF + wc * 32 + 8 * fq;
#pragma unroll
        for (int ai = 0; ai < 2; ++ai)
#pragma unroll
            for (int m = 0; m < 4; ++m) { const int row = row0 + ai * HALF + m * 16;
                const f32x4 g0 = acc[ai][0][m][0], g1 = acc[ai][0][m][1], u0 = acc[ai][1][m][0], u1 = acc[ai][1][m][1];
                f32x4 h0, h1;
#pragma unroll
                for (int i = 0; i < 4; ++i) { h0[i] = silu_f(g0[i]) * u0[i]; h1[i] = silu_f(g1[i]) * u1[i]; }
                u32x4 w; w.x = cvt_pk_bf16(h0[0], h0[1]); w.y = cvt_pk_bf16(h0[2], h0[3]); w.z = cvt_pk_bf16(h1[0], h1[1]); w.w = cvt_pk_bf16(h1[2], h1[3]);
                *(u32x4*)(O + (size_t)row * ldc + col0) = w; }
    }
};
struct EpiResid {
    static constexpr bool PERM = true, AFTER_DRAIN = false;
    const float* xin; float* xout; const float* gate; float alpha;
    __device__ __forceinline__ void operator()(const f32x4 (&acc)[2][2][4][2], const Unit& u, int wr, int wc, int fr, int fq) const {
        const int row0 = u.pm * BM + wr * 64 + fr, col0 = u.pn * BM + wc * 32 + 8 * fq; const int b = u.pm >> 4;
        const float* gp = gate + (size_t)b * 3072 + col0;
#pragma unroll
        for (int bj = 0; bj < 2; ++bj)
#pragma unroll
            for (int n = 0; n < 2; ++n) { const f32x4 gv = *(const f32x4*)(gp + bj * HALF + 4 * n) + 1.0f;
#pragma unroll
                for (int ai = 0; ai < 2; ++ai) {
#pragma unroll
                    for (int m = 0; m < 4; ++m) { const size_t off = (size_t)(row0 + ai * HALF + m * 16) * 1024 + col0 + bj * HALF + 4 * n;
                        const f32x4 x = *(const f32x4*)(xin + off); *(f32x4*)(xout + off) = x * alpha + gv * acc[ai][bj][m][n]; }
                    asm volatile("" ::: "memory"); } }
    }
};
template <class Epi, class Sched, bool ALIGN_EPI = false, bool SP2 = false>
__device__ __forceinline__ void gemm_phase(PG8_LAS unsigned char* lds, const Gemm g, const Sched& S, const Epi& E) {
    const int tid = otid(), wid = __builtin_amdgcn_readfirstlane(tid >> 6), lane = tid & 63, wr = wid >> 2, wc = wid & 3, fr = lane & 15, fq = lane >> 4;
    const int K = g.K, nt = K / BK;
    unsigned voffA[2], voffB[2];
#pragma unroll
    for (int i = 0; i < 2; ++i) { int R, C; stage_rc(tid * 16 + i * 8192, R, C); const int Rb = Epi::PERM ? ((R & ~31) + perm32(R & 31)) : R;
        voffA[i] = (unsigned)(R * K + C) * 2u; voffB[i] = (unsigned)(Rb * K + C) * 2u; }
    const size_t kstep = (size_t)(BK * 2);
    const size_t hstep = (size_t)HALF * K * 2;
    const size_t tstep = 2 * hstep;
    const unsigned ldsw = (unsigned)wid * 1024u;
    const int aoff = lds_byte(wr * 64 + fr, fq * 8), boff = lds_byte(wc * 32 + fr, fq * 8);
#define PG8_SA(b, h) (((b) * 2 + (h)) * HTB)
#define PG8_SB(b, h) ((4 + (b) * 2 + (h)) * HTB)
#define PG8_STAGE(bufoff, gbase, voff) do { _Pragma("unroll") for (int _i = 0; _i < 2; ++_i) \
        __builtin_amdgcn_global_load_lds((const unsigned*)((const char*)(gbase) + (voff)[_i]), (PG8_LAS unsigned*)(lds + (bufoff) + ldsw + _i * 8192), 16, 0, 0); } while (0)
#define PG8_LDA(dst, b, h) do { _Pragma("unroll") for (int m = 0; m < 4; ++m) _Pragma("unroll") for (int k = 0; k < 2; ++k) dst[m][k] = *(const PG8_LAS bf16x8*)(lds + PG8_SA(b, h) + aoff + m * 2048 + k * 1024); } while (0)
#define PG8_LDB(dst, b, h) do { _Pragma("unroll") for (int n = 0; n < 2; ++n) _Pragma("unroll") for (int k = 0; k < 2; ++k) dst[n][k] = *(const PG8_LAS bf16x8*)(lds + PG8_SB(b, h) + boff + n * 2048 + k * 1024); } while (0)
#define PG8_MMA(ai, bj, At, Bt) do { __builtin_amdgcn_s_setprio(1); _Pragma("unroll") for (int m = 0; m < 4; ++m) _Pragma("unroll") for (int n = 0; n < 2; ++n) _Pragma("unroll") for (int k = 0; k < 2; ++k) \
        acc[ai][bj][m][n] = __builtin_amdgcn_mfma_f32_16x16x32_bf16(Bt[n][k], At[m][k], acc[ai][bj][m][n], 0, 0, 0); __builtin_amdgcn_s_setprio(0); } while (0)
#define PG8_WAIT_V(n) asm volatile("s_waitcnt vmcnt(" #n ")" ::: "memory")
#define PG8_WAIT_L(n) asm volatile("s_waitcnt lgkmcnt(" #n ")" ::: "memory")
#define PG8_BAR __builtin_amdgcn_s_barrier()
#define PG8_SCHED __builtin_amdgcn_sched_barrier(0)
    Unit cur, nxt; int ui = 0;
    if (!S.next(0, cur)) return;
    f32x4 acc[2][2][4][2];
#pragma unroll
    for (int a = 0; a < 2; ++a)
#pragma unroll
        for (int b = 0; b < 2; ++b)
#pragma unroll
            for (int m = 0; m < 4; ++m)
#pragma unroll
                for (int n = 0; n < 2; ++n) acc[a][b][m][n] = (f32x4){0.f, 0.f, 0.f, 0.f};
    bf16x8 At[4][2], B0[2][2], B1[2][2];
    const char* cA = (const char*)g.A + (size_t)cur.pm * tstep; const char* cB = (const char*)g.Bt + (size_t)cur.pn * tstep;
    S.a_ready(cur);
    if constexpr (SP2) {
        PG8_STAGE(PG8_SB(0, 0), cB, voffB); PG8_STAGE(PG8_SB(0, 1), cB + hstep, voffB); PG8_STAGE(PG8_SA(0, 0), cA, voffA); PG8_STAGE(PG8_SA(0, 1), cA + hstep, voffA);
        if (wr == 1) PG8_BAR;
        PG8_WAIT_V(2); PG8_BAR;
        PG8_STAGE(PG8_SB(1, 0), cB + kstep, voffB); PG8_STAGE(PG8_SA(1, 0), cA + kstep, voffA); PG8_STAGE(PG8_SB(1, 1), cB + hstep + kstep, voffB);
        PG8_WAIT_V(6); PG8_BAR;
    } else {
        PG8_STAGE(PG8_SB(0, 0), cB, voffB); PG8_STAGE(PG8_SA(0, 0), cA, voffA); PG8_STAGE(PG8_SB(0, 1), cB + hstep, voffB); PG8_STAGE(PG8_SA(0, 1), cA + hstep, voffA);
        if (wr == 1) PG8_BAR;
        PG8_WAIT_V(4); PG8_BAR;
        PG8_STAGE(PG8_SB(1, 0), cB + kstep, voffB); PG8_STAGE(PG8_SA(1, 0), cA + kstep, voffA); PG8_STAGE(PG8_SB(1, 1), cB + hstep + kstep, voffB);
        PG8_WAIT_V(6); PG8_BAR;
    }
    for (;;) {
        const bool has_next = S.next(ui + 1, nxt);
        const char* nA = has_next ? (const char*)g.A + (size_t)nxt.pm * tstep : cA; const char* nB = has_next ? (const char*)g.Bt + (size_t)nxt.pn * tstep : cB;
        for (int t = 0; t < nt; t += 2) {
            const bool last = (t == nt - 2);
            const char* a1 = cA + (size_t)(t + 1) * kstep;
            const char* a2 = last ? nA : cA + (size_t)(t + 2) * kstep; const char* b2 = last ? nB : cB + (size_t)(t + 2) * kstep;
            const char* a3 = a2 + kstep; const char* b3 = b2 + kstep;
            if (last && has_next) S.a_ready(nxt);
            if constexpr (SP2) {
            PG8_LDB(B0, 0, 0); PG8_LDB(B1, 0, 1); PG8_SCHED; PG8_LDA(At, 0, 0); PG8_STAGE(PG8_SA(1, 1), a1 + hstep, voffA);
            PG8_WAIT_V(8); PG8_WAIT_L(0); PG8_BAR; PG8_MMA(0, 0, At, B0); PG8_MMA(0, 1, At, B1); PG8_BAR; PG8_SCHED;
            PG8_LDA(At, 0, 1); PG8_STAGE(PG8_SB(0, 0), b2, voffB); PG8_STAGE(PG8_SB(0, 1), b2 + hstep, voffB); PG8_STAGE(PG8_SA(0, 0), a2, voffA);
            PG8_WAIT_V(8); PG8_WAIT_L(0); PG8_BAR; PG8_MMA(1, 0, At, B0); PG8_MMA(1, 1, At, B1); PG8_BAR; PG8_SCHED;
            PG8_LDB(B0, 1, 0); PG8_LDB(B1, 1, 1); PG8_SCHED; PG8_LDA(At, 1, 0); PG8_STAGE(PG8_SA(0, 1), a2 + hstep, voffA);
            PG8_WAIT_V(8); PG8_WAIT_L(0); PG8_BAR; PG8_MMA(0, 0, At, B0); PG8_MMA(0, 1, At, B1); PG8_BAR; PG8_SCHED;
            PG8_LDA(At, 1, 1); PG8_STAGE(PG8_SB(1, 0), b3, voffB); PG8_STAGE(PG8_SB(1, 1), b3 + hstep, voffB); PG8_STAGE(PG8_SA(1, 0), a3, voffA);
            PG8_WAIT_V(8); PG8_WAIT_L(0); PG8_BAR; PG8_MMA(1, 0, At, B0); PG8_MMA(1, 1, At, B1); PG8_BAR; PG8_SCHED;
            } else {
            PG8_LDB(B0, 0, 0); PG8_SCHED; PG8_LDA(At, 0, 0); PG8_STAGE(PG8_SA(1, 1), a1 + hstep, voffA);
            PG8_WAIT_L(8); PG8_BAR; PG8_WAIT_L(0); PG8_MMA(0, 0, At, B0); PG8_BAR; PG8_SCHED;
            PG8_LDB(B1, 0, 1); PG8_STAGE(PG8_SB(0, 0), b2, voffB);
            PG8_BAR; PG8_WAIT_L(0); PG8_MMA(0, 1, At, B1); PG8_BAR;
            PG8_LDA(At, 0, 1); PG8_STAGE(PG8_SA(0, 0), a2, voffA);
            PG8_BAR; PG8_WAIT_L(0); PG8_MMA(1, 0, At, B0); PG8_BAR; PG8_SCHED;
            PG8_STAGE(PG8_SB(0, 1), b2 + hstep, voffB);
            PG8_WAIT_V(6); PG8_BAR; PG8_MMA(1, 1, At, B1); PG8_BAR;
            PG8_LDB(B0, 1, 0); PG8_SCHED; PG8_LDA(At, 1, 0); PG8_STAGE(PG8_SA(0, 1), a2 + hstep, voffA);
            PG8_WAIT_L(8); PG8_BAR; PG8_WAIT_L(0); PG8_MMA(0, 0, At, B0); PG8_BAR; PG8_SCHED;
            PG8_LDB(B1, 1, 1); PG8_STAGE(PG8_SB(1, 0), b3, voffB);
            PG8_BAR; PG8_WAIT_L(0); PG8_MMA(0, 1, At, B1); PG8_BAR;
            PG8_LDA(At, 1, 1); PG8_STAGE(PG8_SA(1, 0), a3, voffA);
            PG8_BAR; PG8_WAIT_L(0); PG8_MMA(1, 0, At, B0); PG8_BAR; PG8_SCHED;
            PG8_STAGE(PG8_SB(1, 1), b3 + hstep, voffB);
            PG8_WAIT_V(6); PG8_BAR; PG8_MMA(1, 1, At, B1); PG8_BAR;
            }
        }
        if constexpr (ALIGN_EPI) { if (wr == 0) PG8_BAR; }
        if constexpr (!Epi::AFTER_DRAIN) { E(acc, cur, wr, wc, fr, fq); S.done(cur); }
        if (!has_next) break;
#pragma unroll
        for (int a = 0; a < 2; ++a)
#pragma unroll
            for (int b = 0; b < 2; ++b)
#pragma unroll
                for (int m = 0; m < 4; ++m)
#pragma unroll
                    for (int n = 0; n < 2; ++n) acc[a][b][m][n] = (f32x4){0.f, 0.f, 0.f, 0.f};
        cur = nxt; cA = nA; cB = nB; ++ui;
        if constexpr (ALIGN_EPI) { if (wr == 1) PG8_BAR; }
    }
    PG8_WAIT_V(0);
    if constexpr (!ALIGN_EPI) { if (wr == 0) PG8_BAR; }
    PG8_BAR;
    if constexpr (Epi::AFTER_DRAIN) { E.fused(acc, cur, wr, wc, fr, fq, lds, wid, lane); S.done(cur); }
#undef PG8_SA
#undef PG8_SB
#undef PG8_STAGE
#undef PG8_LDA
#undef PG8_LDB
#undef PG8_MMA
#undef PG8_WAIT_V
#undef PG8_WAIT_L
#undef PG8_BAR
#undef PG8_SCHED
}
}
typedef unsigned short bf16_t;
typedef short bf16x8 __attribute__((ext_vector_type(8)));
typedef short bf16x4 __attribute__((ext_vector_type(4)));
typedef float f32x4 __attribute__((ext_vector_type(4)));
typedef float f32x16 __attribute__((ext_vector_type(16)));
typedef unsigned u32x4 __attribute__((ext_vector_type(4)));
typedef unsigned u32x2 __attribute__((ext_vector_type(2)));
constexpr int M_TOK = 65536, SEQ = 4096, DM = 1024, FFH = 2816, NTHR = 512;
constexpr int LDS_BYTES = 147456;
constexpr float ALPHA = 1.681792830507429f, LAM_INIT = 0.5560582041556406f, LOG2E = 1.4426950408889634f;

__device__ __forceinline__ unsigned pk2(float lo, float hi) { return pg8::cvt_pk_bf16(lo, hi); }
__device__ __forceinline__ float bf2f(unsigned short h) { return __uint_as_float(((unsigned)h) << 16); }
__device__ __forceinline__ unsigned short f2bf(float f) { return (unsigned short)(pk2(f, 0.f) & 0xffffu); }
__device__ __forceinline__ f32x4 mfma16(bf16x8 a, bf16x8 b, f32x4 c) { return __builtin_amdgcn_mfma_f32_16x16x32_bf16(a, b, c, 0, 0, 0); }
__device__ __forceinline__ f32x16 mfma32(bf16x8 a, bf16x8 b, f32x16 c) { return __builtin_amdgcn_mfma_f32_32x32x16_bf16(a, b, c, 0, 0, 0); }
__device__ __forceinline__ float wave_sum(float v) {
#pragma unroll
    for (int o = 1; o < 64; o <<= 1) v += __shfl_xor(v, o);
    return v;
}
__device__ __forceinline__ float sigmoid_f(float x) { return __builtin_amdgcn_rcpf(1.0f + __expf(-x)); }

struct TDesc { const float* src; bf16_t* dst; int K, Nsrc, Ndst, mode, p0, item0; };
__device__ __forceinline__ int src_col(int mode, int p0, int Nsrc, int n) {
    if (mode == 0) return n < Nsrc ? n : -1;
    if (mode == 1) { if (n >= p0) return n; const int P = n & 63, base = n - P; int s = P; if (P >= 4 && P < 8) s = P + 4; else if (P >= 8 && P < 12) s = P - 4; return base + s; }
    const int t = n >> 8, wn = n & 255; return wn < 128 ? 128 * t + wn : FFH + 128 * t + (wn - 128);
}
__device__ __forceinline__ void transpose_item(const TDesc& d, float* scr, int item, int lane) {
    const int nblk = d.Ndst / 32, kb = item / nblk, nb = item % nblk, k0 = 64 * kb, n0 = 32 * nb;
    const int n4 = 4 * (lane & 7), sc = src_col(d.mode, d.p0, d.Nsrc, n0 + n4);
#pragma unroll
    for (int i = 0; i < 8; ++i) { const int kk = 8 * i + (lane >> 3); f32x4 v = {0.f, 0.f, 0.f, 0.f};
        if (sc >= 0) v = *(const f32x4*)(d.src + (size_t)(k0 + kk) * d.Nsrc + sc);
        float* sp = scr + kk * 33 + n4; sp[0] = v[0]; sp[1] = v[1]; sp[2] = v[2]; sp[3] = v[3]; }
    asm volatile("s_waitcnt lgkmcnt(0)" ::: "memory");
    const int c = lane & 7;
#pragma unroll
    for (int j = 0; j < 4; ++j) { const int n = (lane >> 3) + 8 * j; const float* s = scr + (8 * c) * 33 + n;
        u32x4 o; o.x = pk2(s[0 * 33], s[1 * 33]); o.y = pk2(s[2 * 33], s[3 * 33]); o.z = pk2(s[4 * 33], s[5 * 33]); o.w = pk2(s[6 * 33], s[7 * 33]);
        *(u32x4*)(d.dst + (size_t)(n0 + n) * d.K + k0 + 8 * c) = o; }
    asm volatile("s_waitcnt lgkmcnt(0)" ::: "memory");
}
__device__ __forceinline__ void ada_phase(unsigned char* lds, const float* c, const float* ada_w, const float* ada_b, float* mod) {
    float* cond = (float*)lds;
    float* red = cond + 16384;
    const int tid = otid(); bool loaded = false;
    for (int item = blockIdx.x; item < 384; item += gridDim.x) {
        if (!loaded) { for (int idx = tid; idx < 16384; idx += NTHR) { const int b = idx >> 10, d = idx & 1023; const float v = c[idx]; cond[d * 16 + b] = v / (1.0f + expf(-v)); } __syncthreads(); loaded = true; }
        const int is = item / 48, cgp = item % 48, cl = tid & 63, col = cgp * 64 + cl, kg = tid >> 6;
        const float* W = ada_w + (size_t)is * 1024 * 3072 + col;
        f32x4 a0 = {0.f, 0.f, 0.f, 0.f}, a1 = a0, a2 = a0, a3 = a0;
#pragma unroll 4
        for (int k = kg * 128; k < kg * 128 + 128; ++k) { const float w = W[(size_t)k * 3072]; const f32x4* cp = (const f32x4*)(cond + k * 16);
            a0 += cp[0] * w; a1 += cp[1] * w; a2 += cp[2] * w; a3 += cp[3] * w; }
#pragma unroll
        for (int i = 0; i < 4; ++i) { red[(kg * 16 + i) * 64 + cl] = a0[i]; red[(kg * 16 + 4 + i) * 64 + cl] = a1[i]; red[(kg * 16 + 8 + i) * 64 + cl] = a2[i]; red[(kg * 16 + 12 + i) * 64 + cl] = a3[i]; }
        __syncthreads();
#pragma unroll
        for (int r = 0; r < 2; ++r) { const int bb = kg + 8 * r; float s = 0.f;
#pragma unroll
            for (int k8 = 0; k8 < 8; ++k8) s += red[(k8 * 16 + bb) * 64 + cl];
            mod[((size_t)is * 16 + bb) * 3072 + col] = s + ada_b[is * 3072 + col]; }
        __syncthreads();
    }
}
__device__ __forceinline__ void rope_phase(const int* positions, float* rope) {
    for (int idx = blockIdx.x * NTHR + otid(); idx < M_TOK * 8; idx += gridDim.x * NTHR) {
        const int row = idx >> 3, j = idx & 7;
        const float inv = j == 0 ? 1.0f : j == 1 ? 1.9392274e-01f : j == 2 ? 3.7606031e-02f : j == 3 ? 7.2926646e-03f : j == 4 ? 1.4142136e-03f : j == 5 ? 2.7424819e-04f : j == 6 ? 5.3182961e-05f : 1.0313386e-05f;
        const float ang = (float)positions[row] * inv;
        double rev = (double)ang * 0.15915494309189535; rev -= __builtin_rint(rev);
        const float fr = (float)rev;
        rope[(size_t)row * 16 + 2 * j] = __builtin_amdgcn_cosf(fr); rope[(size_t)row * 16 + 2 * j + 1] = __builtin_amdgcn_sinf(fr);
    }
}
template <bool DO_LN> __device__ __forceinline__ void ln_pass(const float* xin, float* xout, const float* g, const float* bb, const float* modn, bf16_t* hbuf) {
    const int tid = otid(), lane = tid & 63, gw = blockIdx.x * 8 + (tid >> 6), NGW = gridDim.x * 8;
    for (int row = gw; row < M_TOK; row += NGW) {
        const f32x4* xr = (const f32x4*)(xin + (size_t)row * DM) + lane; f32x4 v[4];
#pragma unroll
        for (int j = 0; j < 4; ++j) v[j] = __builtin_nontemporal_load(xr + 64 * j);
        if (DO_LN) {
            float s = 0.f;
#pragma unroll
            for (int j = 0; j < 4; ++j) s += (v[j][0] + v[j][1]) + (v[j][2] + v[j][3]);
            const float mean = wave_sum(s) * (1.f / DM); float s2 = 0.f;
#pragma unroll
            for (int j = 0; j < 4; ++j) { v[j] = v[j] - mean; s2 += (v[j][0] * v[j][0] + v[j][1] * v[j][1]) + (v[j][2] * v[j][2] + v[j][3] * v[j][3]); }
            const float rstd = __builtin_amdgcn_rsqf(wave_sum(s2) * (1.f / DM) + 1e-5f);
            f32x4* xo = (f32x4*)(xout + (size_t)row * DM) + lane;
#pragma unroll
            for (int j = 0; j < 4; ++j) { const int col = 4 * (lane + 64 * j); v[j] = v[j] * rstd * *(const f32x4*)(g + col) + *(const f32x4*)(bb + col); xo[64 * j] = v[j]; }
        }
        if (modn) { const float* mb = modn + (size_t)(row >> 12) * 3072;
#pragma unroll
            for (int j = 0; j < 4; ++j) { const int col = 4 * (lane + 64 * j); const f32x4 sh = *(const f32x4*)(mb + col), sc = *(const f32x4*)(mb + 1024 + col);
                const f32x4 h = v[j] * (sc + 1.0f) + sh; u32x2 w; w.x = pk2(h[0], h[1]); w.y = pk2(h[2], h[3]); *(u32x2*)(hbuf + (size_t)row * DM + col) = w; } }
    }
}
__device__ __forceinline__ f32x4 unpack4(u32x2 p) { return (f32x4){__uint_as_float(p.x << 16), __uint_as_float(p.x & 0xffff0000u), __uint_as_float(p.y << 16), __uint_as_float(p.y & 0xffff0000u)}; }
template <bool XIN_F32, bool XOUT_F32> __device__ __forceinline__ void resid_ln_pass(const void* xin, void* xout, const float* gate, const float* g, const float* bb, const float* modn, bf16_t* hbuf, bf16_t* hout) {
    const int tid = otid(), lane = tid & 63, gw = blockIdx.x * 8 + (tid >> 6), NGW = gridDim.x * 8;
    for (int row = gw; row < M_TOK; row += NGW) {
        const u32x2* yr = (const u32x2*)(hbuf + (size_t)row * DM) + lane; f32x4 v[4]; u32x2 yv[4];
        if (XIN_F32) { const f32x4* xr = (const f32x4*)((const float*)xin + (size_t)row * DM) + lane;
#pragma unroll
            for (int j = 0; j < 4; ++j) v[j] = __builtin_nontemporal_load(xr + 64 * j); }
        else { const u32x2* xr = (const u32x2*)((const bf16_t*)xin + (size_t)row * DM) + lane;
#pragma unroll
            for (int j = 0; j < 4; ++j) v[j] = unpack4(xr[64 * j]); }
#pragma unroll
        for (int j = 0; j < 4; ++j) yv[j] = __builtin_nontemporal_load(yr + 64 * j);
        const float* gb = gate + (size_t)(row >> 12) * 3072; float s = 0.f;
#pragma unroll
        for (int j = 0; j < 4; ++j) { const int col = 4 * (lane + 64 * j); const f32x4 gv = *(const f32x4*)(gb + col) + 1.0f;
            v[j] = v[j] * ALPHA + gv * unpack4(yv[j]); s += (v[j][0] + v[j][1]) + (v[j][2] + v[j][3]); }
        const float mean = wave_sum(s) * (1.f / DM); float s2 = 0.f;
#pragma unroll
        for (int j = 0; j < 4; ++j) { v[j] = v[j] - mean; s2 += (v[j][0] * v[j][0] + v[j][1] * v[j][1]) + (v[j][2] * v[j][2] + v[j][3] * v[j][3]); }
        const float rstd = __builtin_amdgcn_rsqf(wave_sum(s2) * (1.f / DM) + 1e-5f);
#pragma unroll
        for (int j = 0; j < 4; ++j) { const int col = 4 * (lane + 64 * j); v[j] = v[j] * rstd * *(const f32x4*)(g + col) + *(const f32x4*)(bb + col);
            if (XOUT_F32) __builtin_nontemporal_store(v[j], (f32x4*)((float*)xout + (size_t)row * DM) + lane + 64 * j);
            else { u32x2 w; w.x = pk2(v[j][0], v[j][1]); w.y = pk2(v[j][2], v[j][3]); ((u32x2*)((bf16_t*)xout + (size_t)row * DM) + lane)[64 * j] = w; } }
        if (modn) { const float* mb = modn + (size_t)(row >> 12) * 3072;
#pragma unroll
            for (int j = 0; j < 4; ++j) { const int col = 4 * (lane + 64 * j); const f32x4 sh = *(const f32x4*)(mb + col), sc = *(const f32x4*)(mb + 1024 + col);
                const f32x4 h = v[j] * (sc + 1.0f) + sh; u32x2 w; w.x = pk2(h[0], h[1]); w.y = pk2(h[2], h[3]); __builtin_nontemporal_store(w, (u32x2*)(hout + (size_t)row * DM + col)); } }
    }
}
__device__ __forceinline__ bf16x8 ldf(const bf16_t* base, int stride, int row0, int k0, int lane) { return *(const bf16x8*)(base + (row0 + (lane & 15)) * stride + k0 + 8 * (lane >> 4)); }
template <int MODE> __device__ __forceinline__ void linattn_phase(unsigned char* lds, const bf16_t* proj, int ldp, bf16_t* hs, const float* aux) {
    constexpr int NET = MODE == 0 ? 5 : 4, DV = MODE == 0 ? 256 : 128, NSL = DV / 64, NH = MODE == 0 ? 4 : 8, QS = 136, SS = 72;
    bf16_t* Qs = (bf16_t*)lds;
    bf16_t* Ks = Qs + 64 * QS;
    bf16_t* KTs = Ks + 64 * QS;
    bf16_t* VTs = KTs + 128 * SS;
    bf16_t* As = VTs + 80 * SS;
    bf16_t* CTs = As + 64 * SS;
    float* fsc = (float*)(CTs + 80 * QS);
    const int tid = otid(), lane = tid & 63, w = tid >> 6, g = lane >> 4, lc = lane & 15;
    const float kscale = 0.08838834764831845f;
    for (int it0 = blockIdx.x; it0 < 256; it0 += gridDim.x) {
        const int item = (gridDim.x == 256) ? ((it0 & 7) * 32 + (it0 >> 3)) : it0;
        const int b = item / (NH * NSL), h = (item / NSL) % NH, es = item % NSL;
        const int qcol = h * 128, kcol = (MODE == 0 ? 512 : 1024) + h * 128, vcol = (MODE == 0 ? 1024 + h * 256 : 2048 + h * 128) + es * 64, hcol = h * DV + es * 64;
        const size_t Rb = (size_t)b * SEQ;
        __syncthreads();
        for (int i = tid; i < 80 * QS / 2; i += NTHR) ((unsigned*)CTs)[i] = 0u;
        if (MODE == 0) for (int i = tid; i < 16 * SS; i += NTHR) VTs[64 * SS + i] = (i < SS) ? (bf16_t)0x3F80 : (bf16_t)0;
        f32x4 CT[NET];
#pragma unroll
        for (int e = 0; e < NET; ++e) CT[e] = (f32x4){0.f, 0.f, 0.f, 0.f};
        float m_prev = 0.f, bgi = 0.f, bgf = 0.f, lbd = 0.f;
        if (MODE == 0) { bgi = aux[h]; bgf = aux[4 + h]; }
        else { const int d = h * 128 + (tid & 127); const float l0 = aux[d], l1 = aux[1024 + d], l2 = aux[2048 + d], l3 = aux[3072 + d];
               const float mx = fmaxf(fmaxf(l0, l1), fmaxf(l2, l3)); const float e0 = expf(l0 - mx), e1 = expf(l1 - mx), e2 = expf(l2 - mx), e3 = expf(l3 - mx); lbd = (e1 + e2) / (e0 + e1 + e2 + e3); }
        bf16x8 rq[2], rk[2], rv; float gi = 0.f, gf = 0.f;
#define LA_LOAD(c_) do { const size_t R0_ = Rb + (size_t)(c_) * 64; \
            _Pragma("unroll") for (int i_ = 0; i_ < 2; ++i_) { const int idx_ = tid + NTHR * i_, t_ = idx_ >> 4, c8_ = idx_ & 15; \
                rq[i_] = *(const bf16x8*)(proj + (R0_ + t_) * ldp + qcol + 8 * c8_); rk[i_] = *(const bf16x8*)(proj + (R0_ + t_) * ldp + kcol + 8 * c8_); } \
            { rv = *(const bf16x8*)(proj + (R0_ + lane) * ldp + vcol + 8 * w); } \
            if (MODE == 0 && w == 7) { gi = bf2f(proj[(R0_ + lane) * ldp + 3072 + h]); gf = bf2f(proj[(R0_ + lane) * ldp + 3076 + h]); } } while (0)
#define LA_SCALARS(fd_) do { const float ip = gi + bgi, x = gf + bgf; const float lf = fminf(x, 0.f) - __logf(1.0f + __expf(-fabsf(x))); \
            float bc = lf; \
            _Pragma("unroll") for (int o = 1; o < 64; o <<= 1) { const float t2 = __shfl_up(bc, o); if (lane >= o) bc += t2; } \
            const float u = ip - bc; float pm = u; \
            _Pragma("unroll") for (int o = 1; o < 64; o <<= 1) { const float t2 = __shfl_up(pm, o); if (lane >= o) pm = fmaxf(pm, t2); } \
            const float Mx = fmaxf(m_prev, pm), mt = bc + Mx; \
            const float blast = __shfl(bc, 63), gg = blast - bc + ip; float gmx = gg; \
            _Pragma("unroll") for (int o = 1; o < 64; o <<= 1) gmx = fmaxf(gmx, __shfl_xor(gmx, o)); \
            const float m_new = fmaxf(blast + m_prev, gmx); \
            (fd_)[lane] = -Mx * LOG2E; (fd_)[64 + lane] = u * LOG2E; (fd_)[128 + lane] = __expf(m_prev - Mx); (fd_)[192 + lane] = __expf(-mt); (fd_)[256 + lane] = __expf(gg - m_new) * kscale; \
            if (lane == 0) (fd_)[384] = __expf(blast + m_prev - m_new); \
            m_prev = m_new; } while (0)
        LA_LOAD(0);
        if (MODE == 0 && w == 7) LA_SCALARS(fsc);
        for (int c = 0; c < 64; ++c) {
            const size_t R0 = Rb + (size_t)c * 64;
            float* fs = (MODE == 0) ? fsc + (c & 1) * 512 : fsc;
#pragma unroll
            for (int i = 0; i < 2; ++i) { const int idx = tid + NTHR * i, t = idx >> 4, c8 = idx & 15; *(bf16x8*)(Qs + t * QS + 8 * c8) = rq[i]; *(bf16x8*)(Ks + t * QS + 8 * c8) = rk[i]; }
            {
#pragma unroll
              for (int j = 0; j < 8; ++j) VTs[(8 * w + j) * SS + lane] = (bf16_t)rv[j]; }
            lds_barrier();
            if (c + 1 < 64) LA_LOAD(c + 1);
            if (MODE == 0) {
            } else {
                const int d = tid & 127, qt = tid >> 7; float cfl[16], kk[16]; float run = 1.f;
#pragma unroll
                for (int i = 0; i < 16; ++i) { const float fp = bf2f(Ks[(16 * qt + i) * QS + d]); const float sg = __builtin_amdgcn_rcpf(1.0f + __expf(-fp)); const float f = lbd + (1.0f - lbd) * sg; run *= f; cfl[i] = run; kk[i] = (1.0f - lbd) * (1.0f - sg); }
                fsc[qt * 128 + d] = run;
                lds_barrier();
                float pre = 1.f, tot = 1.f;
#pragma unroll
                for (int q2 = 0; q2 < 4; ++q2) { const float tv = fsc[q2 * 128 + d]; if (q2 < qt) pre *= tv; tot *= tv; }
                if (qt == 0) fsc[512 + d] = tot;
#pragma unroll
                for (int i = 0; i < 16; ++i) { const int t = 16 * qt + i; const float cf = fmaxf(pre * cfl[i], 1e-30f); const float qv = bf2f(Qs[t * QS + d]) * cf; const bf16_t kt = f2bf(kk[i] * __builtin_amdgcn_rcpf(cf));
                    Qs[t * QS + d] = f2bf(qv); Ks[t * QS + d] = kt; }
                lds_barrier();
            }
            { const bf16x8 k0 = *(const bf16x8*)(Ks + lane * QS + 16 * w), k1 = *(const bf16x8*)(Ks + lane * QS + 16 * w + 8); const float wsv = MODE == 0 ? fs[256 + lane] : 1.0f;
#pragma unroll
              for (int j = 0; j < 8; ++j) { KTs[(16 * w + j) * SS + lane] = MODE == 0 ? f2bf(bf2f((unsigned short)k0[j]) * wsv) : (bf16_t)k0[j];
                  KTs[(16 * w + 8 + j) * SS + lane] = MODE == 0 ? f2bf(bf2f((unsigned short)k1[j]) * wsv) : (bf16_t)k1[j]; } }
            {
                const int ti = w >> 1; bf16x8 aq[4], bk[2][4];
#pragma unroll
                for (int ks = 0; ks < 4; ++ks) { aq[ks] = ldf(Qs, QS, 16 * ti, 32 * ks, lane); bk[0][ks] = ldf(Ks, QS, 16 * (2 * (w & 1)), 32 * ks, lane); bk[1][ks] = ldf(Ks, QS, 16 * (2 * (w & 1) + 1), 32 * ks, lane); }
                f32x4 rowa = {0.f, 0.f, 0.f, 0.f};
                if (MODE == 0) rowa = *(const f32x4*)(fs + 16 * ti + 4 * g);
#pragma unroll
                for (int jj = 0; jj < 2; ++jj) { const int sj = 2 * (w & 1) + jj; f32x4 s = {0.f, 0.f, 0.f, 0.f};
                    if (sj <= ti) {
#pragma unroll
                        for (int ks = 0; ks < 4; ++ks) s = mfma16(aq[ks], bk[jj][ks], s);
                    }
                    const int sx = 16 * sj + lc; const float us = MODE == 0 ? fs[64 + sx] : 0.f; unsigned short av[4];
#pragma unroll
                    for (int r = 0; r < 4; ++r) { const int t = 16 * ti + 4 * g + r; float a = s[r];
                        if (MODE == 0) a = a * kscale * __builtin_amdgcn_exp2f(fminf(rowa[r] + us, 0.f));
                        av[r] = f2bf(sx <= t ? a : 0.f); }
#pragma unroll
                    for (int r = 0; r < 4; ++r) As[(16 * ti + 4 * g + r) * SS + sx] = av[r]; }
            }
            const int ti2 = w & 3, ej0 = (w >> 2) * (MODE == 0 ? 3 : 2), nej = MODE == 0 ? (w < 4 ? 3 : 2) : 2;
            f32x4 accn[3];
            {
                bf16x8 aq2[4], bc[3][4];
#pragma unroll
                for (int ks = 0; ks < 4; ++ks) { aq2[ks] = ldf(Qs, QS, 16 * ti2, 32 * ks, lane);
#pragma unroll
                    for (int j = 0; j < 3; ++j) if (j < nej) bc[j][ks] = ldf(CTs, QS, 16 * (ej0 + j), 32 * ks, lane); }
                f32x4 wint = {1.f, 1.f, 1.f, 1.f};
                if (MODE == 0) wint = *(const f32x4*)(fs + 128 + 16 * ti2 + 4 * g);
#pragma unroll
                for (int j = 0; j < 3; ++j) { accn[j] = (f32x4){0.f, 0.f, 0.f, 0.f};
                    if (j < nej) {
#pragma unroll
                        for (int ks = 0; ks < 4; ++ks) accn[j] = mfma16(aq2[ks], bc[j][ks], accn[j]);
                        if (MODE == 0) accn[j] = accn[j] * wint; } }
            }
            lds_barrier();
            {
                bf16x8 aa[2], bv[3][2];
#pragma unroll
                for (int ks = 0; ks < 2; ++ks) { aa[ks] = ldf(As, SS, 16 * ti2, 32 * ks, lane);
#pragma unroll
                    for (int j = 0; j < 3; ++j) if (j < nej) bv[j][ks] = ldf(VTs, SS, 16 * (ej0 + j), 32 * ks, lane); }
#pragma unroll
                for (int j = 0; j < 3; ++j) if (j < nej) {
#pragma unroll
                    for (int ks = 0; ks < 2; ++ks) accn[j] = mfma16(aa[ks], bv[j][ks], accn[j]); }
            }
            if (MODE == 0 && w >= 4 && lc == 0) *(f32x4*)(fs + 320 + 16 * ti2 + 4 * g) = accn[1];
            {
                const float dec0 = MODE == 0 ? fs[384] : 1.0f; const float dcol = MODE == 1 ? fsc[512 + 16 * w + lc] : 1.0f;
                bf16x8 kt2[2], ve[NET][2];
#pragma unroll
                for (int ks = 0; ks < 2; ++ks) { kt2[ks] = ldf(KTs, SS, 16 * w, 32 * ks, lane);
#pragma unroll
                    for (int e = 0; e < NET; ++e) ve[e][ks] = ldf(VTs, SS, 16 * e, 32 * ks, lane); }
#pragma unroll
                for (int e = 0; e < NET; ++e) { if (MODE == 0) CT[e] = CT[e] * dec0;
#pragma unroll
                    for (int ks = 0; ks < 2; ++ks) CT[e] = mfma16(ve[e][ks], kt2[ks], CT[e]);
                    if (MODE == 1) CT[e] = CT[e] * dcol; }
#pragma unroll
                for (int e = 0; e < NET; ++e)
#pragma unroll
                    for (int r = 0; r < 4; ++r) CTs[(16 * e + 4 * g + r) * QS + 16 * w + lc] = f2bf(CT[e][r]);
            }
            if (MODE == 0 && w == 7 && c + 1 < 64) LA_SCALARS(fsc + ((c + 1) & 1) * 512);
            lds_barrier();
            f32x4 denv = {1.f, 1.f, 1.f, 1.f}, emtv = denv;
            if (MODE == 0) { denv = *(const f32x4*)(fs + 320 + 16 * ti2 + 4 * g); emtv = *(const f32x4*)(fs + 192 + 16 * ti2 + 4 * g); }
#pragma unroll
            for (int j = 0; j < 3; ++j) if (j < nej && ej0 + j < 4) {
#pragma unroll
                for (int r = 0; r < 4; ++r) { const int t = 16 * ti2 + 4 * g + r; float o = accn[j][r];
                    if (MODE == 0) o = o * __builtin_amdgcn_rcpf(fmaxf(fabsf(denv[r]), emtv[r]));
                    hs[(R0 + t) * DM + hcol + 16 * (ej0 + j) + lc] = f2bf(o); } }
        }
#undef LA_LOAD
#undef LA_SCALARS
    }
}
template <int MODE> __device__ __forceinline__ void linattn_post(const bf16_t* hs, const bf16_t* proj, int ldp, const float* normw, bf16_t* y) {
    constexpr int GC = MODE == 0 ? 2048 : 3072, HD = MODE == 0 ? 256 : 128;
    const int tid = otid(), lane = tid & 63, gw = blockIdx.x * 8 + (tid >> 6), NGW = gridDim.x * 8;
    for (int row0 = gw; row0 < M_TOK / 2; row0 += NGW) {
        bf16x8 hv[2][2], gv[2][2];
#pragma unroll
        for (int q = 0; q < 2; ++q)
#pragma unroll
            for (int i = 0; i < 2; ++i) { const size_t row = (size_t)row0 + (size_t)q * (M_TOK / 2); const int v = lane + 64 * i;
                hv[q][i] = __builtin_nontemporal_load((const bf16x8*)(hs + row * DM + 8 * v)); gv[q][i] = __builtin_nontemporal_load((const bf16x8*)(proj + row * ldp + GC + 8 * v)); }
#pragma unroll
        for (int q = 0; q < 2; ++q)
#pragma unroll
            for (int i = 0; i < 2; ++i) { const size_t row = (size_t)row0 + (size_t)q * (M_TOK / 2); const int v = lane + 64 * i;
                float x[8]; float ss = 0.f;
#pragma unroll
                for (int j = 0; j < 8; ++j) { x[j] = bf2f((unsigned short)hv[q][i][j]); ss += x[j] * x[j]; }
#pragma unroll
                for (int o = 1; o < HD / 8; o <<= 1) ss += __shfl_xor(ss, o);
                const float rstd = __builtin_amdgcn_rsqf(ss * (1.0f / HD) + 1e-6f);
                const f32x4 w0 = *(const f32x4*)(normw + 8 * v), w1 = *(const f32x4*)(normw + 8 * v + 4); float o8[8];
#pragma unroll
                for (int j = 0; j < 8; ++j) { const float gt = bf2f((unsigned short)gv[q][i][j]); const float ga = MODE == 0 ? sigmoid_f(gt) : gt * sigmoid_f(gt); o8[j] = x[j] * rstd * (j < 4 ? w0[j] : w1[j - 4]) * ga; }
                u32x4 ov; ov.x = pk2(o8[0], o8[1]); ov.y = pk2(o8[2], o8[3]); ov.z = pk2(o8[4], o8[5]); ov.w = pk2(o8[6], o8[7]);
                *(u32x4*)(y + row * DM + 8 * v) = ov; }
    }
}
typedef short v4i16_t __attribute__((ext_vector_type(4)));
__device__ __forceinline__ bf16x4 vtr(const bf16_t* p) { return __builtin_bit_cast(bf16x4, __builtin_amdgcn_ds_read_tr16_b64_v4i16((LAS v4i16_t*)p)); }
__device__ __forceinline__ void swa_phase(unsigned char* lds, const bf16_t* proj, bf16_t* y, const float* sinks) {
    constexpr int LDP = 1280, KS = 72, VR = 80;
    bf16_t* Ks = (bf16_t*)lds;
    bf16_t* Vs = Ks + 256 * KS;
    const int tid = otid(), lane = tid & 63, w = tid >> 6, g = lane >> 4, lc = lane & 15;
    const float C2 = 0.125f * LOG2E;
    const int vtb = (4 * g + (lc >> 2)) * VR + 4 * (lane & 3);
    bf16x8 kr[4], vr[4];
#define SW_LOAD(item_) do { const int b_ = (item_) >> 6, n_ = ((item_) >> 1) & 31, kvh_ = (item_) & 1; const size_t Rk_ = (size_t)b_ * SEQ + 128 * n_ - 128; const int kk0_ = (n_ == 0) ? 128 : 0; \
        _Pragma("unroll") for (int i_ = 0; i_ < 4; ++i_) { const int idx_ = tid + NTHR * i_, kk_ = idx_ >> 3, c8_ = idx_ & 7; kr[i_] = (bf16x8){0, 0, 0, 0, 0, 0, 0, 0}; vr[i_] = kr[i_]; \
            if (kk_ >= kk0_) { kr[i_] = *(const bf16x8*)(proj + (Rk_ + kk_) * LDP + 1024 + kvh_ * 64 + 8 * c8_); vr[i_] = *(const bf16x8*)(proj + (Rk_ + kk_) * LDP + 1152 + kvh_ * 64 + 8 * c8_); } } } while (0)
    if ((int)blockIdx.x < 1024) SW_LOAD((int)blockIdx.x);
    for (int item = blockIdx.x; item < 1024; item += gridDim.x) {
        const int b = item >> 6, n = (item >> 1) & 31, kvh = item & 1;
        const size_t R0 = (size_t)b * SEQ + 128 * n; const int kk0 = (n == 0) ? 128 : 0;
        __syncthreads();
#pragma unroll
        for (int i = 0; i < 4; ++i) { const int idx = tid + NTHR * i, kk = idx >> 3, c8 = idx & 7; *(bf16x8*)(Ks + kk * KS + 8 * c8) = kr[i]; *(bf16x8*)(Vs + kk * VR + 8 * c8) = vr[i]; }
        __syncthreads();
        if (item + (int)gridDim.x < 1024) SW_LOAD(item + (int)gridDim.x);
        const int hq = kvh * 8 + w; const float sink2 = sinks[hq] * LOG2E;
        bf16x8 qn[2];
#pragma unroll
        for (int ks = 0; ks < 2; ++ks) qn[ks] = *(const bf16x8*)(proj + (R0 + lc) * LDP + hq * 64 + 32 * ks + 8 * g);
        for (int qc = 0; qc < 8; ++qc) {
            const size_t row = R0 + 16 * qc + lc; const int qrel = 16 * qc + lc, T0 = qc & ~1;
            bf16x8 qf[2];
#pragma unroll
            for (int ks = 0; ks < 2; ++ks) qf[ks] = qn[ks];
            if (qc < 7) {
#pragma unroll
                for (int ks = 0; ks < 2; ++ks) qn[ks] = *(const bf16x8*)(proj + (row + 16) * LDP + hq * 64 + 32 * ks + 8 * g); }
            f32x4 s[10]; float mx = sink2;
#pragma unroll
            for (int h5 = 0; h5 < 2; ++h5) { bf16x8 kf[5][2];
#pragma unroll
                for (int i5 = 0; i5 < 5; ++i5)
#pragma unroll
                    for (int ks = 0; ks < 2; ++ks) kf[i5][ks] = *(const bf16x8*)(Ks + (16 * (T0 + 5 * h5 + i5) + lc) * KS + 32 * ks + 8 * g);
#pragma unroll
                for (int i5 = 0; i5 < 5; ++i5) s[5 * h5 + i5] = (f32x4){0.f, 0.f, 0.f, 0.f};
#pragma unroll
                for (int ks = 0; ks < 2; ++ks)
#pragma unroll
                    for (int i5 = 0; i5 < 5; ++i5) s[5 * h5 + i5] = mfma16(kf[i5][ks], qf[ks], s[5 * h5 + i5]); }
#pragma unroll
            for (int i = 0; i < 10; ++i) {
#pragma unroll
                for (int r = 0; r < 4; ++r) { const int kk = 16 * (T0 + i) + 4 * g + r; const bool ok = (kk > qrel) && (kk <= qrel + 128) && (kk >= kk0);
                    s[i][r] = ok ? s[i][r] * C2 : -1e30f; mx = fmaxf(mx, s[i][r]); } }
            mx = fmaxf(mx, __shfl_xor(mx, 16)); mx = fmaxf(mx, __shfl_xor(mx, 32));
            float sum = 0.f;
#pragma unroll
            for (int i = 0; i < 10; ++i)
#pragma unroll
                for (int r = 0; r < 4; ++r) { const float p = __builtin_amdgcn_exp2f(s[i][r] - mx); s[i][r] = p; sum += p; }
            sum += __shfl_xor(sum, 16); sum += __shfl_xor(sum, 32);
            const float inv = __builtin_amdgcn_rcpf(sum + __builtin_amdgcn_exp2f(sink2 - mx));
            f32x4 o[4];
#pragma unroll
            for (int et = 0; et < 4; ++et) o[et] = (f32x4){0.f, 0.f, 0.f, 0.f};
            bf16x4 vf[2][4][2];
#pragma unroll
            for (int et = 0; et < 4; ++et) { const bf16_t* vp = Vs + vtb + 16 * T0 * VR + 16 * et; vf[0][et][0] = vtr(vp); vf[0][et][1] = vtr(vp + 16 * VR); }
#pragma unroll
            for (int ip = 0; ip < 5; ++ip) { u32x4 pw; pw.x = pk2(s[2 * ip][0], s[2 * ip][1]); pw.y = pk2(s[2 * ip][2], s[2 * ip][3]); pw.z = pk2(s[2 * ip + 1][0], s[2 * ip + 1][1]); pw.w = pk2(s[2 * ip + 1][2], s[2 * ip + 1][3]);
                const bf16x8 pb = __builtin_bit_cast(bf16x8, pw);
                if (ip < 4) {
#pragma unroll
                    for (int et = 0; et < 4; ++et) { const bf16_t* vp = Vs + vtb + 16 * (T0 + 2 * ip + 2) * VR + 16 * et; vf[(ip + 1) & 1][et][0] = vtr(vp); vf[(ip + 1) & 1][et][1] = vtr(vp + 16 * VR); } }
#pragma unroll
                for (int et = 0; et < 4; ++et) { const bf16x4 a0 = vf[ip & 1][et][0], a1 = vf[ip & 1][et][1];
                    const bf16x8 a = {a0[0], a0[1], a0[2], a0[3], a1[0], a1[1], a1[2], a1[3]}; o[et] = mfma16(a, pb, o[et]); }
                __builtin_amdgcn_sched_barrier(0); }
#pragma unroll
            for (int et = 0; et < 4; ++et) { u32x2 ov; ov.x = pk2(o[et][0] * inv, o[et][1] * inv); ov.y = pk2(o[et][2] * inv, o[et][3] * inv);
                *(u32x2*)(y + row * DM + hq * 64 + 16 * et + 4 * g) = ov; }
        }
    }
#undef SW_LOAD
}
__device__ __forceinline__ void diff_phase(unsigned char* lds, const bf16_t* proj, bf16_t* y, const float* lamv, const float* normw) {
    constexpr int LDP = 3072, KS = 136, VR = 160, XS = 132;
    bf16_t* Kb = (bf16_t*)lds;
    bf16_t* Vb = Kb + 2 * 64 * KS;
    float* Xs = (float*)lds;
    float* lamp = (float*)(lds + 2 * 64 * KS * 2 + 2 * 64 * VR * 2);
    const int tid = otid(), lane = tid & 63, w = tid >> 6, r = lane & 31, hh = lane >> 5, cm = w >> 2, wq = w & 3;
    const float C2 = 0.125f * LOG2E;
    if (w == 0) { const float p01 = wave_sum(lamv[lane] * lamv[64 + lane]), p23 = wave_sum(lamv[128 + lane] * lamv[192 + lane]); if (lane == 0) lamp[0] = expf(p01) - expf(p23) + LAM_INIT; }
    __syncthreads();
    const float lam = lamp[0];
    bf16x8 rk[2], rv[2]; bool have = false;
    for (int item = blockIdx.x; item < 4096; item += gridDim.x) {
        const int rnd = item >> 8, qb = 31 - 2 * rnd - (((item >> 7) & 1) ^ (rnd & 1)), bh = item & 127, b = bh >> 3, h = bh & 7, NT = 2 * qb + 2;
        const size_t Rb = (size_t)b * SEQ, R0 = Rb + 128 * qb;
        const int kcol = 1024 + h * 128, vcol = 2048 + h * 128, qcol = h * 128 + cm * 64;
        const int itn = item + (int)gridDim.x; const bool has_next = itn < 4096;
        const int bhn = itn & 127;
        const size_t Rbn = (size_t)(bhn >> 3) * SEQ; const int kcoln = 1024 + (bhn & 7) * 128, vcoln = 2048 + (bhn & 7) * 128;
        bf16x8 qf[4];
#pragma unroll
        for (int ks = 0; ks < 4; ++ks) qf[ks] = *(const bf16x8*)(proj + (R0 + 32 * wq + r) * LDP + qcol + 16 * ks + 8 * hh);
        f32x16 O[4];
#pragma unroll
        for (int et = 0; et < 4; ++et)
#pragma unroll
            for (int i = 0; i < 16; ++i) O[et][i] = 0.f;
        float mhat = 0.f, lrun = 0.f;
#define DF_LOADX(Rb_, kc_, vc_, jt_) do { const size_t K0_ = (Rb_) + (size_t)(jt_) * 64; \
            _Pragma("unroll") for (int i_ = 0; i_ < 2; ++i_) { const int idx_ = tid + NTHR * i_; rk[i_] = *(const bf16x8*)(proj + (K0_ + (idx_ >> 4)) * LDP + (kc_) + 8 * (idx_ & 15)); \
                rv[i_] = *(const bf16x8*)(proj + (K0_ + (idx_ >> 4)) * LDP + (vc_) + 8 * (idx_ & 15)); } } while (0)
#define DF_LOAD(jt_) DF_LOADX(Rb, kcol, vcol, jt_)
        if (!have) DF_LOAD(0);
        const int qabs = 128 * qb + 32 * wq + r;
        const int vtb = (4 * (lane >> 5) + ((lane & 15) >> 2)) * VR + 16 * ((lane >> 4) & 1) + 4 * (lane & 3);
        u32x4 pbq[4];
#define DF_VRD(dst_, Vt_, ksp_) do { _Pragma("unroll") for (int et_ = 0; et_ < 4; ++et_) { const bf16_t* vp_ = (Vt_) + vtb + (16 * (ksp_)) * VR + 32 * et_; dst_[et_][0] = vtr(vp_); dst_[et_][1] = vtr(vp_ + 8 * VR); } } while (0)
#define DF_VMM(src_, ksp_) do { const bf16x8 pb_ = __builtin_bit_cast(bf16x8, pbq[ksp_]); \
            _Pragma("unroll") for (int et_ = 0; et_ < 4; ++et_) { const bf16x8 a_ = {src_[et_][0][0], src_[et_][0][1], src_[et_][0][2], src_[et_][0][3], src_[et_][1][0], src_[et_][1][1], src_[et_][1][2], src_[et_][1][3]}; O[et_] = mfma32(a_, pb_, O[et_]); } } while (0)
#define DF_PV(Vt_) do { bf16x4 va_[4][2], vb_[4][2]; \
            DF_VRD(va_, Vt_, 0); __builtin_amdgcn_sched_barrier(0); \
            DF_VRD(vb_, Vt_, 1); DF_VMM(va_, 0); __builtin_amdgcn_sched_barrier(0); \
            DF_VRD(va_, Vt_, 2); DF_VMM(vb_, 1); __builtin_amdgcn_sched_barrier(0); \
            DF_VRD(vb_, Vt_, 3); DF_VMM(va_, 2); __builtin_amdgcn_sched_barrier(0); \
            DF_VMM(vb_, 3); __builtin_amdgcn_sched_barrier(0); } while (0)
#define DF_STORE(b_) do { bf16_t* Kd_ = Kb + (b_) * 64 * KS; bf16_t* Vd_ = Vb + (b_) * 64 * VR; \
            _Pragma("unroll") for (int i_ = 0; i_ < 2; ++i_) { const int idx_ = tid + NTHR * i_; *(bf16x8*)(Kd_ + (idx_ >> 4) * KS + 8 * (idx_ & 15)) = rk[i_]; *(bf16x8*)(Vd_ + (idx_ >> 4) * VR + 8 * (idx_ & 15)) = rv[i_]; } } while (0)
        DF_STORE(0);
        if (NT > 1) DF_LOAD(1);
        __syncthreads();
        for (int jt = 0; jt < NT; ++jt) {
            const bf16_t* Kt = Kb + (jt & 1) * 64 * KS; const bf16_t* Vt = Vb + (jt & 1) * 64 * VR;
            f32x16 s[2];
            { bf16x8 kf[2][4];
#pragma unroll
              for (int kt = 0; kt < 2; ++kt)
#pragma unroll
                for (int ks = 0; ks < 4; ++ks) kf[kt][ks] = *(const bf16x8*)(Kt + (32 * kt + r) * KS + cm * 64 + 16 * ks + 8 * hh);
#pragma unroll
              for (int kt = 0; kt < 2; ++kt)
#pragma unroll
                for (int i = 0; i < 16; ++i) s[kt][i] = -mhat;
              __builtin_amdgcn_sched_barrier(0);
#pragma unroll
              for (int ks = 0; ks < 4; ++ks)
#pragma unroll
                for (int kt = 0; kt < 2; ++kt) s[kt] = mfma32(kf[kt][ks], qf[ks], s[kt]);
            }
            if (jt + 1 < NT) { DF_STORE((jt + 1) & 1);
                if (jt + 2 < NT) DF_LOAD(jt + 2);
                else if (has_next) DF_LOADX(Rbn, kcoln, vcoln, 0); }
            if (jt >= NT - 2) {
#pragma unroll
                for (int kt = 0; kt < 2; ++kt)
#pragma unroll
                    for (int i = 0; i < 16; ++i) { const int key = 64 * jt + 32 * kt + (i & 3) + 8 * (i >> 2) + 4 * hh; if (key > qabs) s[kt][i] = -1e30f; }
            }
            float mx = -1e30f;
#pragma unroll
            for (int kt = 0; kt < 2; ++kt)
#pragma unroll
                for (int i = 0; i < 16; ++i) mx = fmaxf(mx, s[kt][i]);
            mx = fmaxf(mx, __shfl_xor(mx, 32));
            const bool first = (jt == 0);
            if (first || __any(mx > 8.0f)) {
                const float dl = first ? mx : fmaxf(mx, 0.f); mhat += dl;
#pragma unroll
                for (int kt = 0; kt < 2; ++kt)
#pragma unroll
                    for (int i = 0; i < 16; ++i) s[kt][i] -= dl;
                if (!first) { const float f = __builtin_amdgcn_exp2f(-dl); lrun *= f;
#pragma unroll
                    for (int et = 0; et < 4; ++et)
#pragma unroll
                        for (int i = 0; i < 16; ++i) O[et][i] *= f; }
            }
            float sum = 0.f;
#pragma unroll
            for (int kt = 0; kt < 2; ++kt)
#pragma unroll
                for (int i = 0; i < 16; ++i) { const float p = __builtin_amdgcn_exp2f(s[kt][i]); s[kt][i] = p; sum += p; }
            lrun += sum;
#pragma unroll
            for (int kt = 0; kt < 2; ++kt)
#pragma unroll
                for (int sp = 0; sp < 2; ++sp) { u32x4 pw; pw.x = pk2(s[kt][8 * sp + 0], s[kt][8 * sp + 1]); pw.y = pk2(s[kt][8 * sp + 2], s[kt][8 * sp + 3]); pw.z = pk2(s[kt][8 * sp + 4], s[kt][8 * sp + 5]); pw.w = pk2(s[kt][8 * sp + 6], s[kt][8 * sp + 7]);
                    pbq[kt * 2 + sp] = pw; }
            DF_PV(Vt);
            lds_barrier();
        }
#undef DF_PV
#undef DF_VRD
#undef DF_VMM
#undef DF_STORE
#undef DF_LOAD
#undef DF_LOADX
        have = has_next;
        const float ltot = lrun + __shfl_xor(lrun, 32), inv = __builtin_amdgcn_rcpf(ltot);
        if (cm == 1) {
#pragma unroll
            for (int et = 0; et < 4; ++et)
#pragma unroll
                for (int rg = 0; rg < 4; ++rg) { const f32x4 v = {O[et][4 * rg] * inv * lam, O[et][4 * rg + 1] * inv * lam, O[et][4 * rg + 2] * inv * lam, O[et][4 * rg + 3] * inv * lam};
                    *(f32x4*)(Xs + (32 * wq + r) * XS + 32 * et + 8 * rg + 4 * hh) = v; }
        }
        __syncthreads();
        if (cm == 0) {
            float ss = 0.f;
#pragma unroll
            for (int et = 0; et < 4; ++et)
#pragma unroll
                for (int rg = 0; rg < 4; ++rg) { const f32x4 x = *(const f32x4*)(Xs + (32 * wq + r) * XS + 32 * et + 8 * rg + 4 * hh);
#pragma unroll
                    for (int i = 0; i < 4; ++i) { const float v = O[et][4 * rg + i] * inv - x[i]; O[et][4 * rg + i] = v; ss += v * v; } }
            ss += __shfl_xor(ss, 32);
            const float rstd = (1.0f - LAM_INIT) * __builtin_amdgcn_rsqf(ss * (1.0f / 128.0f) + 1e-6f);
#pragma unroll
            for (int et = 0; et < 4; ++et)
#pragma unroll
                for (int rg = 0; rg < 4; ++rg) { const int e = 32 * et + 8 * rg + 4 * hh; const f32x4 nw = *(const f32x4*)(normw + e);
                    u32x2 ov; ov.x = pk2(O[et][4 * rg] * rstd * nw[0], O[et][4 * rg + 1] * rstd * nw[1]); ov.y = pk2(O[et][4 * rg + 2] * rstd * nw[2], O[et][4 * rg + 3] * rstd * nw[3]);
                    *(u32x2*)(y + (R0 + 32 * wq + r) * DM + h * 128 + e) = ov; }
        }
        __syncthreads();
    }
}
struct Args { const void* in[24]; float* out; unsigned char* ws; TDesc td[16]; int ntitems; int pad; };
constexpr size_t MiB = 1u << 20;
constexpr size_t WS_MOD = 1 * MiB;
constexpr size_t WS_ROPE = 4 * MiB;
constexpr size_t WS_W = 8 * MiB;
constexpr size_t WS_H = 112 * MiB;
constexpr size_t WS_Y = 240 * MiB;
constexpr size_t WS_P = 368 * MiB;
constexpr size_t WS_XB = 880 * MiB;
constexpr size_t WS_END = 1008 * MiB;
constexpr int NIN[4] = {3328, 1280, 4096, 3072};
__host__ __device__ constexpr size_t w_in_off(int i) { size_t o = 0; for (int j = 0; j < i; ++j) o += (size_t)NIN[j] * 1024; return o; }
constexpr size_t W_OUT0 = (size_t)(3328 + 1280 + 4096 + 3072) * 1024, W_FI0 = W_OUT0 + 4 * (size_t)1024 * 1024, W_FO0 = W_FI0 + 4 * (size_t)5632 * 1024, W_ENDE = W_FO0 + 4 * (size_t)1024 * 2816;
static_assert(WS_W + W_ENDE * 2 <= WS_H, "weights fit");

#ifndef GEMM_ALIGN
#define GEMM_ALIGN true
#endif
#ifndef GEMM_SP2
#define GEMM_SP2 true
#endif
#ifndef PH_MASK
#define PH_MASK 0xFFFF
#endif
#define PH(b) ((PH_MASK >> (b)) & 1)
#ifndef DUP_MASK
#define DUP_MASK 0
#endif
#ifndef DUP_N
#define DUP_N 1
#endif
#define REP(b) for (int rep_ = 0; rep_ < 1 + DUP_N * ((DUP_MASK >> (b)) & 1); ++rep_)
__global__ void __launch_bounds__(NTHR) fwd_megakernel(Args a) {
    extern __shared__ __attribute__((aligned(16))) unsigned char lds[];
    cg::grid_group grid = cg::this_grid();
    const int tid = otid(), lane = tid & 63, wave = __builtin_amdgcn_readfirstlane(tid >> 6);
    unsigned char* ws = a.ws;
    float* mod = (float*)(ws + WS_MOD); float* rope = (float*)(ws + WS_ROPE);
    bf16_t* wts = (bf16_t*)(ws + WS_W); bf16_t* hbuf = (bf16_t*)(ws + WS_H); bf16_t* ybuf = (bf16_t*)(ws + WS_Y); bf16_t* pbuf = (bf16_t*)(ws + WS_P); bf16_t* xb16 = (bf16_t*)(ws + WS_XB);
    const float* x_in = (const float*)a.in[0]; float* xres = a.out;
    LAS unsigned char* lds3 = (LAS unsigned char*)lds;
    for (int u = tid; u < 64; u += NTHR) ((LAS unsigned*)(lds3 + 131072))[u] = 0u;
    __syncthreads();
    const XcdBarrier xbar = xcd_barrier_post((unsigned*)ws, (volatile LAS unsigned*)(lds3 + 131072 + 32));
#define GSYNC() xcd_barrier(xbar)
    if (PH(0)) REP(0) {
        float* scr = (float*)(lds + wave * 16384);
        const int gw = blockIdx.x * 8 + wave, NGW = gridDim.x * 8;
        for (int it = gw; it < a.ntitems; it += NGW) { int k = 0;
#pragma unroll 1
            for (int j = 1; j < 16; ++j) if (it >= a.td[j].item0) k = j;
            transpose_item(a.td[k], scr, it - a.td[k].item0, lane); }
        __syncthreads();
        ada_phase(lds, (const float*)a.in[1], (const float*)a.in[3], (const float*)a.in[4], mod);
        rope_phase((const int*)a.in[2], rope);
    }
    grid.sync();
    if (PH(1)) ln_pass<false>(x_in, nullptr, nullptr, nullptr, mod, hbuf);
    GSYNC();
#pragma unroll 1
    for (int L = 0; L < 4; ++L) {
        const int nin = L == 0 ? 3328 : L == 1 ? 1280 : L == 2 ? 4096 : 3072;
        const size_t wio = L == 0 ? w_in_off(0) : L == 1 ? w_in_off(1) : L == 2 ? w_in_off(2) : w_in_off(3);
        const float* mod0 = mod + (size_t)(2 * L) * 16 * 3072; const float* mod1 = mod0 + 16 * 3072;
        if (PH(2)) { pg8::Gemm g{hbuf, wts + wio, M_TOK, nin, 1024}; pg8::StaticOrder S; S.init(M_TOK, nin, gridDim.x, blockIdx.x);
          pg8::EpiProj E{pbuf, nin, L == 1 ? 1152 : L == 3 ? 2048 : 0, rope, L == 3 ? 1024 : 0, 0.125f * LOG2E};
          REP(2) pg8::gemm_phase<pg8::EpiProj, pg8::StaticOrder, GEMM_ALIGN, GEMM_SP2>(lds3, g, S, E); }
        GSYNC();
        if (L == 0) { if (PH(3)) { REP(3) linattn_phase<0>(lds, pbuf, 3328, hbuf, (const float*)a.in[8]); GSYNC(); REP(12) linattn_post<0>(hbuf, pbuf, 3328, (const float*)a.in[9], ybuf); } }
        else if (L == 1) { if (PH(4)) REP(4) swa_phase(lds, pbuf, ybuf, (const float*)a.in[12]); }
        else if (L == 2) { if (PH(5)) { REP(5) linattn_phase<1>(lds, pbuf, 4096, hbuf, (const float*)a.in[15]); GSYNC(); REP(12) linattn_post<1>(hbuf, pbuf, 4096, (const float*)a.in[16], ybuf); } }
        else if (PH(6)) { REP(6) diff_phase(lds, pbuf, ybuf, (const float*)a.in[19], (const float*)a.in[20]); }
        GSYNC();
        if (PH(7)) { pg8::Gemm g{ybuf, wts + W_OUT0 + (size_t)L * 1024 * 1024, M_TOK, 1024, 1024}; pg8::StaticOrder S; S.init(M_TOK, 1024, gridDim.x, blockIdx.x);
          pg8::EpiProj E{hbuf, 1024, 0, rope, 0, 1.0f};
          REP(7) pg8::gemm_phase<pg8::EpiProj, pg8::StaticOrder, GEMM_ALIGN, GEMM_SP2>(lds3, g, S, E); }
        GSYNC();
        if (L == 0) resid_ln_pass<true, true>(x_in, xres, mod0 + 2048, (const float*)a.in[5] + (2 * L) * 1024, (const float*)a.in[6] + (2 * L) * 1024, mod1, hbuf, hbuf);
        else resid_ln_pass<true, true>(xres, xres, mod0 + 2048, (const float*)a.in[5] + (2 * L) * 1024, (const float*)a.in[6] + (2 * L) * 1024, mod1, hbuf, hbuf);
        GSYNC();
        if (PH(9)) { pg8::Gemm g{hbuf, wts + W_FI0 + (size_t)L * 5632 * 1024, M_TOK, 5632, 1024}; pg8::StaticOrder S; S.init(M_TOK, 5632, gridDim.x, blockIdx.x);
          pg8::EpiSwiGLU E{pbuf, FFH};
          REP(9) pg8::gemm_phase<pg8::EpiSwiGLU, pg8::StaticOrder, GEMM_ALIGN, GEMM_SP2>(lds3, g, S, E); }
        GSYNC();
        if (PH(10)) { pg8::Gemm g{pbuf, wts + W_FO0 + (size_t)L * 1024 * 2816, M_TOK, 1024, FFH}; pg8::StaticOrder S; S.init(M_TOK, 1024, gridDim.x, blockIdx.x);
          pg8::EpiProj E{hbuf, 1024, 0, rope, 0, 1.0f};
          REP(7) pg8::gemm_phase<pg8::EpiProj, pg8::StaticOrder, GEMM_ALIGN, GEMM_SP2>(lds3, g, S, E); }
        GSYNC();
        if (L < 3) resid_ln_pass<true, true>(xres, xres, mod1 + 2048, (const float*)a.in[5] + (2 * L + 1) * 1024, (const float*)a.in[6] + (2 * L + 1) * 1024, mod1 + 16 * 3072, hbuf, hbuf);
        else resid_ln_pass<true, true>(xres, xres, mod1 + 2048, (const float*)a.in[5] + (2 * L + 1) * 1024, (const float*)a.in[6] + (2 * L + 1) * 1024, nullptr, hbuf, hbuf);
        if (L < 3) GSYNC();
        if ((DUP_MASK >> 13) & 1) { for (int q_ = 0; q_ < 8; ++q_) GSYNC(); }
    }
}

extern "C" void kernel_launch(void* const* d_in, const int* in_sizes, int n_in, void* d_out, int out_size, void* d_ws, size_t ws_size, hipStream_t stream) {
    static int grid = 0;
    if (grid == 0) {
        if (n_in != 24 || out_size != M_TOK * DM || ws_size < WS_END) { fprintf(stderr, "kernel_launch: unexpected shapes (n_in %d out %d ws %zu)\n", n_in, out_size, ws_size); grid = -1; return; }
        int dev = 0, cus = 0, per_cu = 0;
        hipGetDevice(&dev); hipDeviceGetAttribute(&cus, hipDeviceAttributeMultiprocessorCount, dev);
        hipFuncSetAttribute((const void*)fwd_megakernel, hipFuncAttributeMaxDynamicSharedMemorySize, LDS_BYTES);
        hipOccupancyMaxActiveBlocksPerMultiprocessor(&per_cu, (const void*)fwd_megakernel, NTHR, LDS_BYTES);
        (void)hipGetLastError();
        if (per_cu < 1) per_cu = 1;
        grid = cus * per_cu;
        fprintf(stderr, "kernel_launch: cus %d per_cu %d grid %d\n", cus, per_cu, grid);
    }
    if (grid < 0) return;
    if (hipMemsetAsync(d_ws, 0, 16384, stream) != hipSuccess) { fprintf(stderr, "memset failed\n"); return; }
    Args a{};
    for (int i = 0; i < 24; ++i) a.in[i] = d_in[i];
    a.out = (float*)d_out; a.ws = (unsigned char*)d_ws;
    bf16_t* wts = (bf16_t*)((unsigned char*)d_ws + WS_W);
    int nt = 0, k = 0;
    auto add = [&](const float* src, bf16_t* dst, int K, int Nsrc, int Ndst, int mode, int p0) { a.td[k] = TDesc{src, dst, K, Nsrc, Ndst, mode, p0, nt}; nt += (K / 64) * (Ndst / 32); ++k; };
    const int inidx[4] = {7, 11, 14, 18}, outidx[4] = {10, 13, 17, 21}, nsrc[4] = {3080, 1280, 4096, 3072}, ropec[4] = {0, 1152, 0, 2048};
    for (int L = 0; L < 4; ++L) add((const float*)d_in[inidx[L]], wts + w_in_off(L), 1024, nsrc[L], NIN[L], ropec[L] ? 1 : 0, ropec[L]);
    for (int L = 0; L < 4; ++L) add((const float*)d_in[outidx[L]], wts + W_OUT0 + (size_t)L * 1024 * 1024, 1024, 1024, 1024, 0, 0);
    for (int L = 0; L < 4; ++L) add((const float*)d_in[22] + (size_t)L * 1024 * 5632, wts + W_FI0 + (size_t)L * 5632 * 1024, 1024, 5632, 5632, 2, 0);
    for (int L = 0; L < 4; ++L) add((const float*)d_in[23] + (size_t)L * 2816 * 1024, wts + W_FO0 + (size_t)L * 1024 * 2816, 2816, 1024, 1024, 0, 0);
    a.ntitems = nt;
    void* args[] = {&a};
    hipError_t e = hipLaunchCooperativeKernel((const void*)fwd_megakernel, dim3(grid), dim3(NTHR), args, LDS_BYTES, stream);
    if (e != hipSuccess) fprintf(stderr, "cooperative launch failed: %s (grid %d)\n", hipGetErrorString(e), grid);
}
```

```cpp
#include <hip/hip_runtime.h>
#include <hip/hip_cooperative_groups.h>
#include <cstdio>
#include <cstdint>
namespace cg = cooperative_groups;
__device__ __forceinline__ int otid() { int t = threadIdx.x; asm volatile("" : "+v"(t)); return t; }
__device__ __forceinline__ void lds_barrier() { asm volatile("s_waitcnt lgkmcnt(0)\n\ts_barrier" ::: "memory"); }
#define GAS __attribute__((address_space(1)))
#define LAS __attribute__((address_space(3)))
#define XB_TMO      128
#define XB_XCNT(j)  (256  + 64 * (j))
#define XB_XSUB(j)  (1280 + 64 * (j))
#define XB_XGEN(j)  (2304 + 64 * (j))
#define XB_TOP      3328
#define XB_TOPGEN   3392
#define XCD_BAR_WORDS 3456
#define XB_SPIN_CAP (1u << 22)

__device__ __forceinline__ unsigned xb_ld(unsigned* p)              { return __hip_atomic_load(p, __ATOMIC_RELAXED, __HIP_MEMORY_SCOPE_AGENT); }
__device__ __forceinline__ unsigned xb_add(unsigned* p, unsigned v) { return __hip_atomic_fetch_add(p, v, __ATOMIC_RELAXED, __HIP_MEMORY_SCOPE_AGENT); }
__device__ __forceinline__ unsigned xb_xcc_id() { return (unsigned)__builtin_amdgcn_s_getreg((3 << 11) | 20) & 0xFu; }
#define XB_SPIN(cond, bar) do { unsigned _sp = 0; while (cond) { __builtin_amdgcn_s_sleep(1); \
    if ((++_sp & 255u) == 0u) { if (xb_ld(&(bar)[XB_TMO])) break; if (_sp > XB_SPIN_CAP) { atomicAdd(&(bar)[XB_TMO], 1u); break; } } } } while (0)

struct XcdBarrier {
    unsigned* bar; unsigned x;
    volatile LAS unsigned* st;
};

__device__ __forceinline__ XcdBarrier xcd_barrier_post(unsigned* bar, volatile LAS unsigned* st) {
    XcdBarrier b; b.bar = bar; b.x = xb_xcc_id(); b.st = st;
    if (threadIdx.x == 0) (void)xb_add(&bar[XB_XCNT(b.x)], 1u);
    return b;
}
__device__ __forceinline__ void xcd_barrier_complete(unsigned* bar, unsigned x, unsigned& nloc, unsigned& nx) {
    const unsigned G = gridDim.x * gridDim.y * gridDim.z;
    unsigned sum, cnt, mine, sp = 0u;
    for (;;) {
        sum = 0u; cnt = 0u; mine = 0u;
#pragma unroll
        for (unsigned j = 0; j < 16; ++j) { const unsigned c = xb_ld(&bar[XB_XCNT(j)]); sum += c; cnt += (c > 0u) ? 1u : 0u; mine = (j == x) ? c : mine; }
        if (sum == G) break;
        __builtin_amdgcn_s_sleep(1);
        if ((++sp & 255u) == 0u) { if (xb_ld(&bar[XB_TMO])) break; if (sp > XB_SPIN_CAP) { atomicAdd(&bar[XB_TMO], 1u); break; } }
    }
    nloc = mine > 0u ? mine : 1u; nx = cnt > 0u ? cnt : 1u;
}

__device__ __forceinline__ void xcd_barrier(const XcdBarrier& b) {
    asm volatile("s_waitcnt vmcnt(0)" ::: "memory");
    __syncthreads();
    if (threadIdx.x == 0) {
        unsigned* bar = b.bar;
        __builtin_amdgcn_s_waitcnt(0);
        unsigned nloc = b.st[0], nx = b.st[1];
        if (nloc == 0u) { xcd_barrier_complete(bar, b.x, nloc, nx); b.st[0] = nloc; b.st[1] = nx; }
        const unsigned old = xb_add(&bar[XB_XSUB(b.x)], 1u);
        const unsigned gen = old / nloc;
        if (old + 1u == (gen + 1u) * nloc) {
            __builtin_amdgcn_fence(__ATOMIC_RELEASE, "agent");
            asm volatile("s_waitcnt vmcnt(0)" ::: "memory");
            const unsigned og = xb_add(&bar[XB_TOP], 1u);
            const unsigned tg = og / nx;
            if (og + 1u == (tg + 1u) * nx) xb_add(&bar[XB_TOPGEN], 1u);
            else XB_SPIN(xb_ld(&bar[XB_TOPGEN]) == tg, bar);
            __builtin_amdgcn_fence(__ATOMIC_ACQUIRE, "agent");
            xb_add(&bar[XB_XGEN(b.x)], 1u);
            asm volatile("s_waitcnt vmcnt(0)" ::: "memory");
        } else {
            XB_SPIN(xb_ld(&bar[XB_XGEN(b.x)]) == gen, bar);
            __builtin_amdgcn_fence(__ATOMIC_ACQUIRE, "agent");
            asm volatile("s_waitcnt vmcnt(0)" ::: "memory");
        }
    }
    __syncthreads();
}
namespace pg8 {
#define PG8_LAS __attribute__((address_space(3)))
typedef unsigned short bf16_t;
typedef short bf16x8 __attribute__((ext_vector_type(8)));
typedef float f32x4 __attribute__((ext_vector_type(4)));
typedef unsigned u32x4 __attribute__((ext_vector_type(4)));
constexpr int BM = 256, BK = 64, HALF = 128, HTB = HALF * BK * 2  , STAGE_BYTES = 8 * HTB, NXCD = 8, WGM = 8;

__host__ __device__ __forceinline__ int lds_byte(int r, int c) { const int st = (r >> 4) * 2 + (c >> 5), rr = r & 15, cc = c & 31, ob = rr * 64 + cc * 2; return st * 1024 + (ob ^ (((ob >> 9) & 1) << 5)); }
__host__ __device__ __forceinline__ void stage_rc(int b, int& R, int& C) { const int st = b / 1024, sb = b % 1024, swz = sb ^ (((sb >> 9) & 1) << 5); R = (st >> 1) * 16 + swz / 64; C = (st & 1) * 32 + (swz % 64) / 2; }
__host__ __device__ __forceinline__ int perm32(int rho) { const int n = rho >> 4, i = rho & 15; return 8 * (i >> 2) + 4 * n + (i & 3); }

struct Unit { int pm, pn; };
struct Gemm { const bf16_t* A; const bf16_t* Bt; int M, N, K; };

struct StaticOrder {
    int nM, nN, nwg, G, c;
    __host__ __device__ void init(int M, int N, int G_, int c_) { nM = M / BM; nN = N / BM; nwg = nM * nN; G = G_; c = c_; }
    __host__ __device__ bool next(int i, Unit& u) const {
        const long L = (long)i * G + c; if (L >= nwg) return false;
        int wgid = (int)L; { const int q = nwg / NXCD, r = nwg % NXCD, xcd = wgid % NXCD, off = wgid / NXCD; wgid = (xcd < r ? xcd * (q + 1) : r * (q + 1) + (xcd - r) * q) + off; }
        const int nig = WGM * nN, gid = wgid / nig, fm = gid * WGM, gsz = (nM - fm) < WGM ? (nM - fm) : WGM;
        u.pm = fm + ((wgid % nig) % gsz); u.pn = (wgid % nig) / gsz; return true;
    }
    __device__ __forceinline__ void a_ready(const Unit&) const {}
    __device__ __forceinline__ void done(const Unit&) const {}
};

typedef float f32x2_t __attribute__((ext_vector_type(2))); typedef __bf16 bf16x2_t __attribute__((ext_vector_type(2)));
__device__ __forceinline__ unsigned cvt_pk_bf16(float lo, float hi) { f32x2_t v = {lo, hi}; bf16x2_t b = __builtin_convertvector(v, bf16x2_t); return __builtin_bit_cast(unsigned, b); }
typedef unsigned u32x2 __attribute__((ext_vector_type(2)));
struct EpiProj {
    static constexpr bool PERM = true, AFTER_DRAIN = false;
    bf16_t* O; int ldc; int rope_cols; const float* rope; int qs_cols; float qs;
    __device__ __forceinline__ void operator()(const f32x4 (&acc)[2][2][4][2], const Unit& u, int wr, int wc, int fr, int fq) const {
        const int row0 = u.pm * BM + wr * 64 + fr, col0 = u.pn * BM + wc * 32 + 8 * fq;
#pragma unroll
        for (int ai = 0; ai < 2; ++ai)
#pragma unroll
            for (int m = 0; m < 4; ++m) { const int row = row0 + ai * HALF + m * 16; bf16_t* rowp = O + (size_t)row * ldc + col0;
#pragma unroll
                for (int bj = 0; bj < 2; ++bj) { const int col = col0 + bj * HALF; f32x4 v0 = acc[ai][bj][m][0], v1 = acc[ai][bj][m][1];
                    if (col < rope_cols && (col & 63) < 16) { const int j0 = (col & 8) >> 1; const f32x4* rt = (const f32x4*)(rope + (size_t)row * 16 + j0 * 2);
                        const f32x4 t0 = rt[0], t1 = rt[1]; const f32x4 cs = {t0[0], t0[2], t1[0], t1[2]}, sn = {t0[1], t0[3], t1[1], t1[3]};
                        const f32x4 n0 = v0 * cs - v1 * sn, n1 = v1 * cs + v0 * sn; v0 = n0; v1 = n1; }
                    if (col < qs_cols) { v0 = v0 * qs; v1 = v1 * qs; }
                    u32x4 w; w.x = cvt_pk_bf16(v0[0], v0[1]); w.y = cvt_pk_bf16(v0[2], v0[3]); w.z = cvt_pk_bf16(v1[0], v1[1]); w.w = cvt_pk_bf16(v1[2], v1[3]);
                    *(u32x4*)(rowp + bj * HALF) = w; } }
    }
};
__device__ __forceinline__ float silu_f(float g) { return g * __builtin_amdgcn_rcpf(1.0f + __expf(-g)); }
struct EpiSwiGLU {
    static constexpr bool PERM = true, AFTER_DRAIN = false;
    bf16_t* O; int ldc;
    __device__ __forceinline__ void operator()(const f32x4 (&acc)[2][2][4][2], const Unit& u, int wr, int wc, int fr, int fq) const {
        const int row0 = u.pm * BM + wr * 64 + fr, col0 = u.pn * HALF + wc * 32 + 8 * fq;
#pragma unroll
        for (int ai = 0; ai < 2; ++ai)
#pragma unroll
            for (int m = 0; m < 4; ++m) { const int row = row0 + ai * HALF + m * 16;
                const f32x4 g0 = acc[ai][0][m][0], g1 = acc[ai][0][m][1], u0 = acc[ai][1][m][0], u1 = acc[ai][1][m][1];
                f32x4 h0, h1;
#pragma unroll
                for (int i = 0; i < 4; ++i) { h0[i] = silu_f(g0[i]) * u0[i]; h1[i] = silu_f(g1[i]) * u1[i]; }
                u32x4 w; w.x = cvt_pk_bf16(h0[0], h0[1]); w.y = cvt_pk_bf16(h0[2], h0[3]); w.z = cvt_pk_bf16(h1[0], h1[1]); w.w = cvt_pk_bf16(h1[2], h1[3]);
                *(u32x4*)(O + (size_t)row * ldc + col0) = w; }
    }
};
struct EpiResid {
    static constexpr bool PERM = true, AFTER_DRAIN = false;
    const float* xin; float* xout; const float* gate; float alpha;
    __device__ __forceinline__ void operator()(const f32x4 (&acc)[2][2][4][2], const Unit& u, int wr, int wc, int fr, int fq) const {
        const int row0 = u.pm * BM + wr * 64 + fr, col0 = u.pn * BM + wc * 32 + 8 * fq; const int b = u.pm >> 4;
        const float* gp = gate + (size_t)b * 3072 + col0;
#pragma unroll
        for (int bj = 0; bj < 2; ++bj)
#pragma unroll
            for (int n = 0; n < 2; ++n) { const f32x4 gv = *(const f32x4*)(gp + bj * HALF + 4 * n) + 1.0f;
#pragma unroll
                for (int ai = 0; ai < 2; ++ai) {
#pragma unroll
                    for (int m = 0; m < 4; ++m) { const size_t off = (size_t)(row0 + ai * HALF + m * 16) * 1024 + col0 + bj * HALF + 4 * n;
                        const f32x4 x = *(const f32x4*)(xin + off); *(f32x4*)(xout + off) = x * alpha + gv * acc[ai][bj][m][n]; }
                    asm volatile("" ::: "memory"); } }
    }
};
template <class Epi, class Sched, bool ALIGN_EPI = false, bool SP2 = false>
__device__ __forceinline__ void gemm_phase(PG8_LAS unsigned char* lds, const Gemm g, const Sched& S, const Epi& E) {
    const int tid = otid(), wid = __builtin_amdgcn_readfirstlane(tid >> 6), lane = tid & 63, wr = wid >> 2, wc = wid & 3, fr = lane & 15, fq = lane >> 4;
    const int K = g.K, nt = K / BK;
    unsigned voffA[2], voffB[2];
#pragma unroll
    for (int i = 0; i < 2; ++i) { int R, C; stage_rc(tid * 16 + i * 8192, R, C); const int Rb = Epi::PERM ? ((R & ~31) + perm32(R & 31)) : R;
        voffA[i] = (unsigned)(R * K + C) * 2u; voffB[i] = (unsigned)(Rb * K + C) * 2u; }
    const size_t kstep = (size_t)(BK * 2);
    const size_t hstep = (size_t)HALF * K * 2;
    const size_t tstep = 2 * hstep;
    const unsigned ldsw = (unsigned)wid * 1024u;
    const int aoff = lds_byte(wr * 64 + fr, fq * 8), boff = lds_byte(wc * 32 + fr, fq * 8);
#define PG8_SA(b, h) (((b) * 2 + (h)) * HTB)
#define PG8_SB(b, h) ((4 + (b) * 2 + (h)) * HTB)
#define PG8_STAGE(bufoff, gbase, voff) do { _Pragma("unroll") for (int _i = 0; _i < 2; ++_i) \
        __builtin_amdgcn_global_load_lds((const unsigned*)((const char*)(gbase) + (voff)[_i]), (PG8_LAS unsigned*)(lds + (bufoff) + ldsw + _i * 8192), 16, 0, 0); } while (0)
#define PG8_LDA(dst, b, h) do { _Pragma("unroll") for (int m = 0; m < 4; ++m) _Pragma("unroll") for (int k = 0; k < 2; ++k) dst[m][k] = *(const PG8_LAS bf16x8*)(lds + PG8_SA(b, h) + aoff + m * 2048 + k * 1024); } while (0)
#define PG8_LDB(dst, b, h) do { _Pragma("unroll") for (int n = 0; n < 2; ++n) _Pragma("unroll") for (int k = 0; k < 2; ++k) dst[n][k] = *(const PG8_LAS bf16x8*)(lds + PG8_SB(b, h) + boff + n * 2048 + k * 1024); } while (0)
#define PG8_MMA(ai, bj, At, Bt) do { __builtin_amdgcn_s_setprio(1); _Pragma("unroll") for (int m = 0; m < 4; ++m) _Pragma("unroll") for (int n = 0; n < 2; ++n) _Pragma("unroll") for (int k = 0; k < 2; ++k) \
        acc[ai][bj][m][n] = __builtin_amdgcn_mfma_f32_16x16x32_bf16(Bt[n][k], At[m][k], acc[ai][bj][m][n], 0, 0, 0); __builtin_amdgcn_s_setprio(0); } while (0)
#define PG8_WAIT_V(n) asm volatile("s_waitcnt vmcnt(" #n ")" ::: "memory")
#define PG8_WAIT_L(n) asm volatile("s_waitcnt lgkmcnt(" #n ")" ::: "memory")
#define PG8_BAR __builtin_amdgcn_s_barrier()
#define PG8_SCHED __builtin_amdgcn_sched_barrier(0)
    Unit cur, nxt; int ui = 0;
    if (!S.next(0, cur)) return;
    f32x4 acc[2][2][4][2];
#pragma unroll
    for (int a = 0; a < 2; ++a)
#pragma unroll
        for (int b = 0; b < 2; ++b)
#pragma unroll
            for (int m = 0; m < 4; ++m)
#pragma unroll
                for (int n = 0; n < 2; ++n) acc[a][b][m][n] = (f32x4){0.f, 0.f, 0.f, 0.f};
    bf16x8 At[4][2], B0[2][2], B1[2][2];
    const char* cA = (const char*)g.A + (size_t)cur.pm * tstep; const char* cB = (const char*)g.Bt + (size_t)cur.pn * tstep;
    S.a_ready(cur);
    if constexpr (SP2) {
        PG8_STAGE(PG8_SB(0, 0), cB, voffB); PG8_STAGE(PG8_SB(0, 1), cB + hstep, voffB); PG8_STAGE(PG8_SA(0, 0), cA, voffA); PG8_STAGE(PG8_SA(0, 1), cA + hstep, voffA);
        if (wr == 1) PG8_BAR;
        PG8_WAIT_V(2); PG8_BAR;
        PG8_STAGE(PG8_SB(1, 0), cB + kstep, voffB); PG8_STAGE(PG8_SA(1, 0), cA + kstep, voffA); PG8_STAGE(PG8_SB(1, 1), cB + hstep + kstep, voffB);
        PG8_WAIT_V(6); PG8_BAR;
    } else {
        PG8_STAGE(PG8_SB(0, 0), cB, voffB); PG8_STAGE(PG8_SA(0, 0), cA, voffA); PG8_STAGE(PG8_SB(0, 1), cB + hstep, voffB); PG8_STAGE(PG8_SA(0, 1), cA + hstep, voffA);
        if (wr == 1) PG8_BAR;
        PG8_WAIT_V(4); PG8_BAR;
        PG8_STAGE(PG8_SB(1, 0), cB + kstep, voffB); PG8_STAGE(PG8_SA(1, 0), cA + kstep, voffA); PG8_STAGE(PG8_SB(1, 1), cB + hstep + kstep, voffB);
        PG8_WAIT_V(6); PG8_BAR;
    }
    for (;;) {
        const bool has_next = S.next(ui + 1, nxt);
        const char* nA = has_next ? (const char*)g.A + (size_t)nxt.pm * tstep : cA; const char* nB = has_next ? (const char*)g.Bt + (size_t)nxt.pn * tstep : cB;
        for (int t = 0; t < nt; t += 2) {
            const bool last = (t == nt - 2);
            const char* a1 = cA + (size_t)(t + 1) * kstep;
            const char* a2 = last ? nA : cA + (size_t)(t + 2) * kstep; const char* b2 = last ? nB : cB + (size_t)(t + 2) * kstep;
            const char* a3 = a2 + kstep; const char* b3 = b2 + kstep;
            if (last && has_next) S.a_ready(nxt);
            if constexpr (SP2) {
            PG8_LDB(B0, 0, 0); PG8_LDB(B1, 0, 1); PG8_SCHED; PG8_LDA(At, 0, 0); PG8_STAGE(PG8_SA(1, 1), a1 + hstep, voffA);
            PG8_WAIT_V(8); PG8_WAIT_L(0); PG8_BAR; PG8_MMA(0, 0, At, B0); PG8_MMA(0, 1, At, B1); PG8_BAR; PG8_SCHED;
            PG8_LDA(At, 0, 1); PG8_STAGE(PG8_SB(0, 0), b2, voffB); PG8_STAGE(PG8_SB(0, 1), b2 + hstep, voffB); PG8_STAGE(PG8_SA(0, 0), a2, voffA);
            PG8_WAIT_V(8); PG8_WAIT_L(0); PG8_BAR; PG8_MMA(1, 0, At, B0); PG8_MMA(1, 1, At, B1); PG8_BAR; PG8_SCHED;
            PG8_LDB(B0, 1, 0); PG8_LDB(B1, 1, 1); PG8_SCHED; PG8_LDA(At, 1, 0); PG8_STAGE(PG8_SA(0, 1), a2 + hstep, voffA);
            PG8_WAIT_V(8); PG8_WAIT_L(0); PG8_BAR; PG8_MMA(0, 0, At, B0); PG8_MMA(0, 1, At, B1); PG8_BAR; PG8_SCHED;
            PG8_LDA(At, 1, 1); PG8_STAGE(PG8_SB(1, 0), b3, voffB); PG8_STAGE(PG8_SB(1, 1), b3 + hstep, voffB); PG8_STAGE(PG8_SA(1, 0), a3, voffA);
            PG8_WAIT_V(8); PG8_WAIT_L(0); PG8_BAR; PG8_MMA(1, 0, At, B0); PG8_MMA(1, 1, At, B1); PG8_BAR; PG8_SCHED;
            } else {
            PG8_LDB(B0, 0, 0); PG8_SCHED; PG8_LDA(At, 0, 0); PG8_STAGE(PG8_SA(1, 1), a1 + hstep, voffA);
            PG8_WAIT_L(8); PG8_BAR; PG8_WAIT_L(0); PG8_MMA(0, 0, At, B0); PG8_BAR; PG8_SCHED;
            PG8_LDB(B1, 0, 1); PG8_STAGE(PG8_SB(0, 0), b2, voffB);
            PG8_BAR; PG8_WAIT_L(0); PG8_MMA(0, 1, At, B1); PG8_BAR;
            PG8_LDA(At, 0, 1); PG8_STAGE(PG8_SA(0, 0), a2, voffA);
            PG8_BAR; PG8_WAIT_L(0); PG8_MMA(1, 0, At, B0); PG8_BAR; PG8_SCHED;
            PG8_STAGE(PG8_SB(0, 1), b2 + hstep, voffB);
            PG8_WAIT_V(6); PG8_BAR; PG8_MMA(1, 1, At, B1); PG8_BAR;
            PG8_LDB(B0, 1, 0); PG8_SCHED; PG8_LDA(At, 1, 0); PG8_STAGE(PG8_SA(0, 1), a2 + hstep, voffA);
            PG8_WAIT_L(8); PG8_BAR; PG8_WAIT_L(0); PG8_MMA(0, 0, At, B0); PG8_BAR; PG8_SCHED;
            PG8_LDB(B1, 1, 1); PG8_STAGE(PG8_SB(1, 0), b3, voffB);
            PG8_BAR; PG8_WAIT_L(0); PG8_MMA(0, 1, At, B1); PG8_BAR;
            PG8_LDA(At, 1, 1); PG8_STAGE(PG8_SA(1, 0), a3, voffA);
            PG8_BAR; PG8_WAIT_L(0); PG8_MMA(1, 0, At, B0); PG8_BAR; PG8_SCHED;
            PG8_STAGE(PG8_SB(1, 1), b3 + hstep, voffB);
            PG8_WAIT_V(6); PG8_BAR; PG8_MMA(1, 1, At, B1); PG8_BAR;
            }
        }
        if constexpr (ALIGN_EPI) { if (wr == 0) PG8_BAR; }
        if constexpr (!Epi::AFTER_DRAIN) { E(acc, cur, wr, wc, fr, fq); S.done(cur); }
        if (!has_next) break;
#pragma unroll
        for (int a = 0; a < 2; ++a)
#pragma unroll
            for (int b = 0; b < 2; ++b)
#pragma unroll
                for (int m = 0; m < 4; ++m)
#pragma unroll
                    for (int n = 0; n < 2; ++n) acc[a][b][m][n] = (f32x4){0.f, 0.f, 0.f, 0.f};
        cur = nxt; cA = nA; cB = nB; ++ui;
        if constexpr (ALIGN_EPI) { if (wr == 1) PG8_BAR; }
    }
    PG8_WAIT_V(0);
    if constexpr (!ALIGN_EPI) { if (wr == 0) PG8_BAR; }
    PG8_BAR;
    if constexpr (Epi::AFTER_DRAIN) { E.fused(acc, cur, wr, wc, fr, fq, lds, wid, lane); S.done(cur); }
#undef PG8_SA
#undef PG8_SB
#undef PG8_STAGE
#undef PG8_LDA
#undef PG8_LDB
#undef PG8_MMA
#undef PG8_WAIT_V
#undef PG8_WAIT_L
#undef PG8_BAR
#undef PG8_SCHED
}
}
typedef unsigned short bf16_t;
typedef short bf16x8 __attribute__((ext_vector_type(8)));
typedef short bf16x4 __attribute__((ext_vector_type(4)));
typedef float f32x4 __attribute__((ext_vector_type(4)));
typedef float f32x16 __attribute__((ext_vector_type(16)));
typedef unsigned u32x4 __attribute__((ext_vector_type(4)));
typedef unsigned u32x2 __attribute__((ext_vector_type(2)));
constexpr int M_TOK = 65536, SEQ = 4096, DM = 1024, FFH = 2816, NTHR = 512;
constexpr int LDS_BYTES = 147456;
constexpr float ALPHA = 1.681792830507429f, LAM_INIT = 0.5560582041556406f, LOG2E = 1.4426950408889634f;

__device__ __forceinline__ unsigned pk2(float lo, float hi) { return pg8::cvt_pk_bf16(lo, hi); }
__device__ __forceinline__ float bf2f(unsigned short h) { return __uint_as_float(((unsigned)h) << 16); }
__device__ __forceinline__ unsigned short f2bf(float f) { return (unsigned short)(pk2(f, 0.f) & 0xffffu); }
__device__ __forceinline__ f32x4 mfma16(bf16x8 a, bf16x8 b, f32x4 c) { return __builtin_amdgcn_mfma_f32_16x16x32_bf16(a, b, c, 0, 0, 0); }
__device__ __forceinline__ f32x16 mfma32(bf16x8 a, bf16x8 b, f32x16 c) { return __builtin_amdgcn_mfma_f32_32x32x16_bf16(a, b, c, 0, 0, 0); }
__device__ __forceinline__ float wave_sum(float v) {
#pragma unroll
    for (int o = 1; o < 64; o <<= 1) v += __shfl_xor(v, o);
    return v;
}
__device__ __forceinline__ float sigmoid_f(float x) { return __builtin_amdgcn_rcpf(1.0f + __expf(-x)); }

struct TDesc { const float* src; bf16_t* dst; int K, Nsrc, Ndst, mode, p0, item0; };
__device__ __forceinline__ int src_col(int mode, int p0, int Nsrc, int n) {
    if (mode == 0) return n < Nsrc ? n : -1;
    if (mode == 1) { if (n >= p0) return n; const int P = n & 63, base = n - P; int s = P; if (P >= 4 && P < 8) s = P + 4; else if (P >= 8 && P < 12) s = P - 4; return base + s; }
    const int t = n >> 8, wn = n & 255; return wn < 128 ? 128 * t + wn : FFH + 128 * t + (wn - 128);
}
__device__ __forceinline__ void transpose_item(const TDesc& d, float* scr, int item, int lane) {
    const int nblk = d.Ndst / 32, kb = item / nblk, nb = item % nblk, k0 = 64 * kb, n0 = 32 * nb;
    const int n4 = 4 * (lane & 7), sc = src_col(d.mode, d.p0, d.Nsrc, n0 + n4);
#pragma unroll
    for (int i = 0; i < 8; ++i) { const int kk = 8 * i + (lane >> 3); f32x4 v = {0.f, 0.f, 0.f, 0.f};
        if (sc >= 0) v = *(const f32x4*)(d.src + (size_t)(k0 + kk) * d.Nsrc + sc);
        float* sp = scr + kk * 33 + n4; sp[0] = v[0]; sp[1] = v[1]; sp[2] = v[2]; sp[3] = v[3]; }
    asm volatile("s_waitcnt lgkmcnt(0)" ::: "memory");
    const int c = lane & 7;
#pragma unroll
    for (int j = 0; j < 4; ++j) { const int n = (lane >> 3) + 8 * j; const float* s = scr + (8 * c) * 33 + n;
        u32x4 o; o.x = pk2(s[0 * 33], s[1 * 33]); o.y = pk2(s[2 * 33], s[3 * 33]); o.z = pk2(s[4 * 33], s[5 * 33]); o.w = pk2(s[6 * 33], s[7 * 33]);
        *(u32x4*)(d.dst + (size_t)(n0 + n) * d.K + k0 + 8 * c) = o; }
    asm volatile("s_waitcnt lgkmcnt(0)" ::: "memory");
}
__device__ __forceinline__ void ada_phase(unsigned char* lds, const float* c, const float* ada_w, const float* ada_b, float* mod) {
    float* cond = (float*)lds;
    float* red = cond + 16384;
    const int tid = otid(); bool loaded = false;
    for (int item = blockIdx.x; item < 384; item += gridDim.x) {
        if (!loaded) { for (int idx = tid; idx < 16384; idx += NTHR) { const int b = idx >> 10, d = idx & 1023; const float v = c[idx]; cond[d * 16 + b] = v / (1.0f + expf(-v)); } __syncthreads(); loaded = true; }
        const int is = item / 48, cgp = item % 48, cl = tid & 63, col = cgp * 64 + cl, kg = tid >> 6;
        const float* W = ada_w + (size_t)is * 1024 * 3072 + col;
        f32x4 a0 = {0.f, 0.f, 0.f, 0.f}, a1 = a0, a2 = a0, a3 = a0;
#pragma unroll 4
        for (int k = kg * 128; k < kg * 128 + 128; ++k) { const float w = W[(size_t)k * 3072]; const f32x4* cp = (const f32x4*)(cond + k * 16);
            a0 += cp[0] * w; a1 += cp[1] * w; a2 += cp[2] * w; a3 += cp[3] * w; }
#pragma unroll
        for (int i = 0; i < 4; ++i) { red[(kg * 16 + i) * 64 + cl] = a0[i]; red[(kg * 16 + 4 + i) * 64 + cl] = a1[i]; red[(kg * 16 + 8 + i) * 64 + cl] = a2[i]; red[(kg * 16 + 12 + i) * 64 + cl] = a3[i]; }
        __syncthreads();
#pragma unroll
        for (int r = 0; r < 2; ++r) { const int bb = kg + 8 * r; float s = 0.f;
#pragma unroll
            for (int k8 = 0; k8 < 8; ++k8) s += red[(k8 * 16 + bb) * 64 + cl];
            mod[((size_t)is * 16 + bb) * 3072 + col] = s + ada_b[is * 3072 + col]; }
        __syncthreads();
    }
}
__device__ __forceinline__ void rope_phase(const int* positions, float* rope) {
    for (int idx = blockIdx.x * NTHR + otid(); idx < M_TOK * 8; idx += gridDim.x * NTHR) {
        const int row = idx >> 3, j = idx & 7;
        const float inv = j == 0 ? 1.0f : j == 1 ? 1.9392274e-01f : j == 2 ? 3.7606031e-02f : j == 3 ? 7.2926646e-03f : j == 4 ? 1.4142136e-03f : j == 5 ? 2.7424819e-04f : j == 6 ? 5.3182961e-05f : 1.0313386e-05f;
        const float ang = (float)positions[row] * inv;
        double rev = (double)ang * 0.15915494309189535; rev -= __builtin_rint(rev);
        const float fr = (float)rev;
        rope[(size_t)row * 16 + 2 * j] = __builtin_amdgcn_cosf(fr); rope[(size_t)row * 16 + 2 * j + 1] = __builtin_amdgcn_sinf(fr);
    }
}
template <bool DO_LN> __device__ __forceinline__ void ln_pass(const float* xin, float* xout, const float* g, const float* bb, const float* modn, bf16_t* hbuf) {
    const int tid = otid(), lane = tid & 63, gw = blockIdx.x * 8 + (tid >> 6), NGW = gridDim.x * 8;
    for (int row = gw; row < M_TOK; row += NGW) {
        const f32x4* xr = (const f32x4*)(xin + (size_t)row * DM) + lane; f32x4 v[4];
#pragma unroll
        for (int j = 0; j < 4; ++j) v[j] = __builtin_nontemporal_load(xr + 64 * j);
        if (DO_LN) {
            float s = 0.f;
#pragma unroll
            for (int j = 0; j < 4; ++j) s += (v[j][0] + v[j][1]) + (v[j][2] + v[j][3]);
            const float mean = wave_sum(s) * (1.f / DM); float s2 = 0.f;
#pragma unroll
            for (int j = 0; j < 4; ++j) { v[j] = v[j] - mean; s2 += (v[j][0] * v[j][0] + v[j][1] * v[j][1]) + (v[j][2] * v[j][2] + v[j][3] * v[j][3]); }
            const float rstd = __builtin_amdgcn_rsqf(wave_sum(s2) * (1.f / DM) + 1e-5f);
            f32x4* xo = (f32x4*)(xout + (size_t)row * DM) + lane;
#pragma unroll
            for (int j = 0; j < 4; ++j) { const int col = 4 * (lane + 64 * j); v[j] = v[j] * rstd * *(const f32x4*)(g + col) + *(const f32x4*)(bb + col); xo[64 * j] = v[j]; }
        }
        if (modn) { const float* mb = modn + (size_t)(row >> 12) * 3072;
#pragma unroll
            for (int j = 0; j < 4; ++j) { const int col = 4 * (lane + 64 * j); const f32x4 sh = *(const f32x4*)(mb + col), sc = *(const f32x4*)(mb + 1024 + col);
                const f32x4 h = v[j] * (sc + 1.0f) + sh; u32x2 w; w.x = pk2(h[0], h[1]); w.y = pk2(h[2], h[3]); *(u32x2*)(hbuf + (size_t)row * DM + col) = w; } }
    }
}
__device__ __forceinline__ f32x4 unpack4(u32x2 p) { return (f32x4){__uint_as_float(p.x << 16), __uint_as_float(p.x & 0xffff0000u), __uint_as_float(p.y << 16), __uint_as_float(p.y & 0xffff0000u)}; }
template <bool XIN_F32, bool XOUT_F32> __device__ __forceinline__ void resid_ln_pass(const void* xin, void* xout, const float* gate, const float* g, const float* bb, const float* modn, bf16_t* hbuf, bf16_t* hout) {
    const int tid = otid(), lane = tid & 63, gw = blockIdx.x * 8 + (tid >> 6), NGW = gridDim.x * 8;
    for (int row = gw; row < M_TOK; row += NGW) {
        const u32x2* yr = (const u32x2*)(hbuf + (size_t)row * DM) + lane; f32x4 v[4]; u32x2 yv[4];
        if (XIN_F32) { const f32x4* xr = (const f32x4*)((const float*)xin + (size_t)row * DM) + lane;
#pragma unroll
            for (int j = 0; j < 4; ++j) v[j] = __builtin_nontemporal_load(xr + 64 * j); }
        else { const u32x2* xr = (const u32x2*)((const bf16_t*)xin + (size_t)row * DM) + lane;
#pragma unroll
            for (int j = 0; j < 4; ++j) v[j] = unpack4(xr[64 * j]); }
#pragma unroll
        for (int j = 0; j < 4; ++j) yv[j] = __builtin_nontemporal_load(yr + 64 * j);
        const float* gb = gate + (size_t)(row >> 12) * 3072; float s = 0.f;
#pragma unroll
        for (int j = 0; j < 4; ++j) { const int col = 4 * (lane + 64 * j); const f32x4 gv = *(const f32x4*)(gb + col) + 1.0f;
            v[j] = v[j] * ALPHA + gv * unpack4(yv[j]); s += (v[j][0] + v[j][1]) + (v[j][2] + v[j][3]); }
        const float mean = wave_sum(s) * (1.f / DM); float s2 = 0.f;
#pragma unroll
        for (int j = 0; j < 4; ++j) { v[j] = v[j] - mean; s2 += (v[j][0] * v[j][0] + v[j][1] * v[j][1]) + (v[j][2] * v[j][2] + v[j][3] * v[j][3]); }
        const float rstd = __builtin_amdgcn_rsqf(wave_sum(s2) * (1.f / DM) + 1e-5f);
#pragma unroll
        for (int j = 0; j < 4; ++j) { const int col = 4 * (lane + 64 * j); v[j] = v[j] * rstd * *(const f32x4*)(g + col) + *(const f32x4*)(bb + col);
            if (XOUT_F32) __builtin_nontemporal_store(v[j], (f32x4*)((float*)xout + (size_t)row * DM) + lane + 64 * j);
            else { u32x2 w; w.x = pk2(v[j][0], v[j][1]); w.y = pk2(v[j][2], v[j][3]); ((u32x2*)((bf16_t*)xout + (size_t)row * DM) + lane)[64 * j] = w; } }
        if (modn) { const float* mb = modn + (size_t)(row >> 12) * 3072;
#pragma unroll
            for (int j = 0; j < 4; ++j) { const int col = 4 * (lane + 64 * j); const f32x4 sh = *(const f32x4*)(mb + col), sc = *(const f32x4*)(mb + 1024 + col);
                const f32x4 h = v[j] * (sc + 1.0f) + sh; u32x2 w; w.x = pk2(h[0], h[1]); w.y = pk2(h[2], h[3]); __builtin_nontemporal_store(w, (u32x2*)(hout + (size_t)row * DM + col)); } }
    }
}
__device__ __forceinline__ bf16x8 ldf(const bf16_t* base, int stride, int row0, int k0, int lane) { return *(const bf16x8*)(base + (row0 + (lane & 15)) * stride + k0 + 8 * (lane >> 4)); }
template <int MODE> __device__ __forceinline__ void linattn_phase(unsigned char* lds, const bf16_t* proj, int ldp, bf16_t* hs, const float* aux) {
    constexpr int NET = MODE == 0 ? 5 : 4, DV = MODE == 0 ? 256 : 128, NSL = DV / 64, NH = MODE == 0 ? 4 : 8, QS = 136, SS = 72;
    bf16_t* Qs = (bf16_t*)lds;
    bf16_t* Ks = Qs + 64 * QS;
    bf16_t* KTs = Ks + 64 * QS;
    bf16_t* VTs = KTs + 128 * SS;
    bf16_t* As = VTs + 80 * SS;
    bf16_t* CTs = As + 64 * SS;
    float* fsc = (float*)(CTs + 80 * QS);
    const int tid = otid(), lane = tid & 63, w = tid >> 6, g = lane >> 4, lc = lane & 15;
    const float kscale = 0.08838834764831845f;
    for (int it0 = blockIdx.x; it0 < 256; it0 += gridDim.x) {
        const int item = (gridDim.x == 256) ? ((it0 & 7) * 32 + (it0 >> 3)) : it0;
        const int b = item / (NH * NSL), h = (item / NSL) % NH, es = item % NSL;
        const int qcol = h * 128, kcol = (MODE == 0 ? 512 : 1024) + h * 128, vcol = (MODE == 0 ? 1024 + h * 256 : 2048 + h * 128) + es * 64, hcol = h * DV + es * 64;
        const size_t Rb = (size_t)b * SEQ;
        __syncthreads();
        for (int i = tid; i < 80 * QS / 2; i += NTHR) ((unsigned*)CTs)[i] = 0u;
        if (MODE == 0) for (int i = tid; i < 16 * SS; i += NTHR) VTs[64 * SS + i] = (i < SS) ? (bf16_t)0x3F80 : (bf16_t)0;
        f32x4 CT[NET];
#pragma unroll
        for (int e = 0; e < NET; ++e) CT[e] = (f32x4){0.f, 0.f, 0.f, 0.f};
        float m_prev = 0.f, bgi = 0.f, bgf = 0.f, lbd = 0.f;
        if (MODE == 0) { bgi = aux[h]; bgf = aux[4 + h]; }
        else { const int d = h * 128 + (tid & 127); const float l0 = aux[d], l1 = aux[1024 + d], l2 = aux[2048 + d], l3 = aux[3072 + d];
               const float mx = fmaxf(fmaxf(l0, l1), fmaxf(l2, l3)); const float e0 = expf(l0 - mx), e1 = expf(l1 - mx), e2 = expf(l2 - mx), e3 = expf(l3 - mx); lbd = (e1 + e2) / (e0 + e1 + e2 + e3); }
        bf16x8 rq[2], rk[2], rv; float gi = 0.f, gf = 0.f;
#define LA_LOAD(c_) do { const size_t R0_ = Rb + (size_t)(c_) * 64; \
            _Pragma("unroll") for (int i_ = 0; i_ < 2; ++i_) { const int idx_ = tid + NTHR * i_, t_ = idx_ >> 4, c8_ = idx_ & 15; \
                rq[i_] = *(const bf16x8*)(proj + (R0_ + t_) * ldp + qcol + 8 * c8_); rk[i_] = *(const bf16x8*)(proj + (R0_ + t_) * ldp + kcol + 8 * c8_); } \
            { rv = *(const bf16x8*)(proj + (R0_ + lane) * ldp + vcol + 8 * w); } \
            if (MODE == 0 && w == 7) { gi = bf2f(proj[(R0_ + lane) * ldp + 3072 + h]); gf = bf2f(proj[(R0_ + lane) * ldp + 3076 + h]); } } while (0)
#define LA_SCALARS(fd_) do { const float ip = gi + bgi, x = gf + bgf; const float lf = fminf(x, 0.f) - __logf(1.0f + __expf(-fabsf(x))); \
            float bc = lf; \
            _Pragma("unroll") for (int o = 1; o < 64; o <<= 1) { const float t2 = __shfl_up(bc, o); if (lane >= o) bc += t2; } \
            const float u = ip - bc; float pm = u; \
            _Pragma("unroll") for (int o = 1; o < 64; o <<= 1) { const float t2 = __shfl_up(pm, o); if (lane >= o) pm = fmaxf(pm, t2); } \
            const float Mx = fmaxf(m_prev, pm), mt = bc + Mx; \
            const float blast = __shfl(bc, 63), gg = blast - bc + ip; float gmx = gg; \
            _Pragma("unroll") for (int o = 1; o < 64; o <<= 1) gmx = fmaxf(gmx, __shfl_xor(gmx, o)); \
            const float m_new = fmaxf(blast + m_prev, gmx); \
            (fd_)[lane] = -Mx; (fd_)[64 + lane] = u; (fd_)[128 + lane] = __expf(m_prev - Mx); (fd_)[192 + lane] = __expf(-mt); (fd_)[256 + lane] = __expf(gg - m_new) * kscale; \
            if (lane == 0) (fd_)[384] = __expf(blast + m_prev - m_new); \
            m_prev = m_new; } while (0)
        LA_LOAD(0);
        if (MODE == 0 && w == 7) LA_SCALARS(fsc);
        for (int c = 0; c < 64; ++c) {
            const size_t R0 = Rb + (size_t)c * 64;
            float* fs = (MODE == 0) ? fsc + (c & 1) * 512 : fsc;
#pragma unroll
            for (int i = 0; i < 2; ++i) { const int idx = tid + NTHR * i, t = idx >> 4, c8 = idx & 15; *(bf16x8*)(Qs + t * QS + 8 * c8) = rq[i]; *(bf16x8*)(Ks + t * QS + 8 * c8) = rk[i]; }
            {
#pragma unroll
              for (int j = 0; j < 8; ++j) VTs[(8 * w + j) * SS + lane] = (bf16_t)rv[j]; }
            lds_barrier();
            if (c + 1 < 64) LA_LOAD(c + 1);
            if (MODE == 0) {
            } else {
                const int d = tid & 127, qt = tid >> 7; float cfl[16], kk[16]; float run = 1.f;
#pragma unroll
                for (int i = 0; i < 16; ++i) { const float fp = bf2f(Ks[(16 * qt + i) * QS + d]); const float sg = __builtin_amdgcn_rcpf(1.0f + __expf(-fp)); const float f = lbd + (1.0f - lbd) * sg; run *= f; cfl[i] = run; kk[i] = (1.0f - lbd) * (1.0f - sg); }
                fsc[qt * 128 + d] = run;
                lds_barrier();
                float pre = 1.f, tot = 1.f;
#pragma unroll
                for (int q2 = 0; q2 < 4; ++q2) { const float tv = fsc[q2 * 128 + d]; if (q2 < qt) pre *= tv; tot *= tv; }
                if (qt == 0) fsc[512 + d] = tot;
#pragma unroll
                for (int i = 0; i < 16; ++i) { const int t = 16 * qt + i; const float cf = fmaxf(pre * cfl[i], 1e-30f); const float qv = bf2f(Qs[t * QS + d]) * cf; const bf16_t kt = f2bf(kk[i] * __builtin_amdgcn_rcpf(cf));
                    Qs[t * QS + d] = f2bf(qv); Ks[t * QS + d] = kt; }
                lds_barrier();
            }
            { const bf16x8 k0 = *(const bf16x8*)(Ks + lane * QS + 16 * w), k1 = *(const bf16x8*)(Ks + lane * QS + 16 * w + 8); const float wsv = MODE == 0 ? fs[256 + lane] : 1.0f;
#pragma unroll
              for (int j = 0; j < 8; ++j) { KTs[(16 * w + j) * SS + lane] = MODE == 0 ? f2bf(bf2f((unsigned short)k0[j]) * wsv) : (bf16_t)k0[j];
                  KTs[(16 * w + 8 + j) * SS + lane] = MODE == 0 ? f2bf(bf2f((unsigned short)k1[j]) * wsv) : (bf16_t)k1[j]; } }
            {
                const int ti = w >> 1; bf16x8 aq[4], bk[2][4];
#pragma unroll
                for (int ks = 0; ks < 4; ++ks) { aq[ks] = ldf(Qs, QS, 16 * ti, 32 * ks, lane); bk[0][ks] = ldf(Ks, QS, 16 * (2 * (w & 1)), 32 * ks, lane); bk[1][ks] = ldf(Ks, QS, 16 * (2 * (w & 1) + 1), 32 * ks, lane); }
                f32x4 rowa = {0.f, 0.f, 0.f, 0.f};
                if (MODE == 0) rowa = *(const f32x4*)(fs + 16 * ti + 4 * g);
#pragma unroll
                for (int jj = 0; jj < 2; ++jj) { const int sj = 2 * (w & 1) + jj; f32x4 s = {0.f, 0.f, 0.f, 0.f};
                    if (sj <= ti) {
#pragma unroll
                        for (int ks = 0; ks < 4; ++ks) s = mfma16(aq[ks], bk[jj][ks], s);
                    }
                    const int sx = 16 * sj + lc; const float us = MODE == 0 ? fs[64 + sx] : 0.f; unsigned short av[4];
#pragma unroll
                    for (int r = 0; r < 4; ++r) { const int t = 16 * ti + 4 * g + r; float a = s[r];
                        if (MODE == 0) a = a * kscale * __expf(fminf(rowa[r] + us, 0.f));
                        av[r] = f2bf(sx <= t ? a : 0.f); }
#pragma unroll
                    for (int r = 0; r < 4; ++r) As[(16 * ti + 4 * g + r) * SS + sx] = av[r]; }
            }
            const int ti2 = w & 3, ej0 = (w >> 2) * (MODE == 0 ? 3 : 2), nej = MODE == 0 ? (w < 4 ? 3 : 2) : 2;
            f32x4 accn[3];
            {
                bf16x8 aq2[4], bc[3][4];
#pragma unroll
                for (int ks = 0; ks < 4; ++ks) { aq2[ks] = ldf(Qs, QS, 16 * ti2, 32 * ks, lane);
#pragma unroll
                    for (int j = 0; j < 3; ++j) if (j < nej) bc[j][ks] = ldf(CTs, QS, 16 * (ej0 + j), 32 * ks, lane); }
                f32x4 wint = {1.f, 1.f, 1.f, 1.f};
                if (MODE == 0) wint = *(const f32x4*)(fs + 128 + 16 * ti2 + 4 * g);
#pragma unroll
                for (int j = 0; j < 3; ++j) { accn[j] = (f32x4){0.f, 0.f, 0.f, 0.f};
                    if (j < nej) {
#pragma unroll
                        for (int ks = 0; ks < 4; ++ks) accn[j] = mfma16(aq2[ks], bc[j][ks], accn[j]);
                        if (MODE == 0) accn[j] = accn[j] * wint; } }
            }
            lds_barrier();
            {
                bf16x8 aa[2], bv[3][2];
#pragma unroll
                for (int ks = 0; ks < 2; ++ks) { aa[ks] = ldf(As, SS, 16 * ti2, 32 * ks, lane);
#pragma unroll
                    for (int j = 0; j < 3; ++j) if (j < nej) bv[j][ks] = ldf(VTs, SS, 16 * (ej0 + j), 32 * ks, lane); }
#pragma unroll
                for (int j = 0; j < 3; ++j) if (j < nej) {
#pragma unroll
                    for (int ks = 0; ks < 2; ++ks) accn[j] = mfma16(aa[ks], bv[j][ks], accn[j]); }
            }
            if (MODE == 0 && w >= 4 && lc == 0) *(f32x4*)(fs + 320 + 16 * ti2 + 4 * g) = accn[1];
            {
                const float dec0 = MODE == 0 ? fs[384] : 1.0f; const float dcol = MODE == 1 ? fsc[512 + 16 * w + lc] : 1.0f;
                bf16x8 kt2[2], ve[NET][2];
#pragma unroll
                for (int ks = 0; ks < 2; ++ks) { kt2[ks] = ldf(KTs, SS, 16 * w, 32 * ks, lane);
#pragma unroll
                    for (int e = 0; e < NET; ++e) ve[e][ks] = ldf(VTs, SS, 16 * e, 32 * ks, lane); }
#pragma unroll
                for (int e = 0; e < NET; ++e) { if (MODE == 0) CT[e] = CT[e] * dec0;
#pragma unroll
                    for (int ks = 0; ks < 2; ++ks) CT[e] = mfma16(ve[e][ks], kt2[ks], CT[e]);
                    if (MODE == 1) CT[e] = CT[e] * dcol; }
#pragma unroll
                for (int e = 0; e < NET; ++e)
#pragma unroll
                    for (int r = 0; r < 4; ++r) CTs[(16 * e + 4 * g + r) * QS + 16 * w + lc] = f2bf(CT[e][r]);
            }
            if (MODE == 0 && w == 7 && c + 1 < 64) LA_SCALARS(fsc + ((c + 1) & 1) * 512);
            lds_barrier();
            f32x4 denv = {1.f, 1.f, 1.f, 1.f}, emtv = denv;
            if (MODE == 0) { denv = *(const f32x4*)(fs + 320 + 16 * ti2 + 4 * g); emtv = *(const f32x4*)(fs + 192 + 16 * ti2 + 4 * g); }
#pragma unroll
            for (int j = 0; j < 3; ++j) if (j < nej && ej0 + j < 4) {
#pragma unroll
                for (int r = 0; r < 4; ++r) { const int t = 16 * ti2 + 4 * g + r; float o = accn[j][r];
                    if (MODE == 0) o = o * __builtin_amdgcn_rcpf(fmaxf(fabsf(denv[r]), emtv[r]));
                    hs[(R0 + t) * DM + hcol + 16 * (ej0 + j) + lc] = f2bf(o); } }
        }
#undef LA_LOAD
#undef LA_SCALARS
    }
}
template <int MODE> __device__ __forceinline__ void linattn_post(const bf16_t* hs, const bf16_t* proj, int ldp, const float* normw, bf16_t* y) {
    constexpr int GC = MODE == 0 ? 2048 : 3072, HD = MODE == 0 ? 256 : 128;
    const int tid = otid(), lane = tid & 63, gw = blockIdx.x * 8 + (tid >> 6), NGW = gridDim.x * 8;
    for (int row0 = gw; row0 < M_TOK / 2; row0 += NGW) {
        bf16x8 hv[2][2], gv[2][2];
#pragma unroll
        for (int q = 0; q < 2; ++q)
#pragma unroll
            for (int i = 0; i < 2; ++i) { const size_t row = (size_t)row0 + (size_t)q * (M_TOK / 2); const int v = lane + 64 * i;
                hv[q][i] = __builtin_nontemporal_load((const bf16x8*)(hs + row * DM + 8 * v)); gv[q][i] = __builtin_nontemporal_load((const bf16x8*)(proj + row * ldp + GC + 8 * v)); }
#pragma unroll
        for (int q = 0; q < 2; ++q)
#pragma unroll
            for (int i = 0; i < 2; ++i) { const size_t row = (size_t)row0 + (size_t)q * (M_TOK / 2); const int v = lane + 64 * i;
                float x[8]; float ss = 0.f;
#pragma unroll
                for (int j = 0; j < 8; ++j) { x[j] = bf2f((unsigned short)hv[q][i][j]); ss += x[j] * x[j]; }
#pragma unroll
                for (int o = 1; o < HD / 8; o <<= 1) ss += __shfl_xor(ss, o);
                const float rstd = __builtin_amdgcn_rsqf(ss * (1.0f / HD) + 1e-6f);
                const f32x4 w0 = *(const f32x4*)(normw + 8 * v), w1 = *(const f32x4*)(normw + 8 * v + 4); float o8[8];
#pragma unroll
                for (int j = 0; j < 8; ++j) { const float gt = bf2f((unsigned short)gv[q][i][j]); const float ga = MODE == 0 ? sigmoid_f(gt) : gt * sigmoid_f(gt); o8[j] = x[j] * rstd * (j < 4 ? w0[j] : w1[j - 4]) * ga; }
                u32x4 ov; ov.x = pk2(o8[0], o8[1]); ov.y = pk2(o8[2], o8[3]); ov.z = pk2(o8[4], o8[5]); ov.w = pk2(o8[6], o8[7]);
                *(u32x4*)(y + row * DM + 8 * v) = ov; }
    }
}
typedef short v4i16_t __attribute__((ext_vector_type(4)));
__device__ __forceinline__ bf16x4 vtr(const bf16_t* p) { return __builtin_bit_cast(bf16x4, __builtin_amdgcn_ds_read_tr16_b64_v4i16((LAS v4i16_t*)p)); }
__device__ __forceinline__ void swa_phase(unsigned char* lds, const bf16_t* proj, bf16_t* y, const float* sinks) {
    constexpr int LDP = 1280, KS = 72, VR = 80;
    bf16_t* Ks = (bf16_t*)lds;
    bf16_t* Vs = Ks + 256 * KS;
    const int tid = otid(), lane = tid & 63, w = tid >> 6, g = lane >> 4, lc = lane & 15;
    const int vtb = (4 * g + (lc >> 2)) * VR + 4 * (lane & 3);
    bf16x8 kr[4], vr[4];
#define SW_LOAD(item_) do { const int b_ = (item_) >> 6, n_ = ((item_) >> 1) & 31, kvh_ = (item_) & 1; const size_t Rk_ = (size_t)b_ * SEQ + 128 * n_ - 128; const int kk0_ = (n_ == 0) ? 128 : 0; \
        _Pragma("unroll") for (int i_ = 0; i_ < 4; ++i_) { const int idx_ = tid + NTHR * i_, kk_ = idx_ >> 3, c8_ = idx_ & 7; kr[i_] = (bf16x8){0, 0, 0, 0, 0, 0, 0, 0}; vr[i_] = kr[i_]; \
            if (kk_ >= kk0_) { kr[i_] = *(const bf16x8*)(proj + (Rk_ + kk_) * LDP + 1024 + kvh_ * 64 + 8 * c8_); vr[i_] = *(const bf16x8*)(proj + (Rk_ + kk_) * LDP + 1152 + kvh_ * 64 + 8 * c8_); } } } while (0)
    if ((int)blockIdx.x < 1024) SW_LOAD((int)blockIdx.x);
    for (int item = blockIdx.x; item < 1024; item += gridDim.x) {
        const int b = item >> 6, n = (item >> 1) & 31, kvh = item & 1;
        const size_t R0 = (size_t)b * SEQ + 128 * n; const int kk0 = (n == 0) ? 128 : 0;
        __syncthreads();
#pragma unroll
        for (int i = 0; i < 4; ++i) { const int idx = tid + NTHR * i, kk = idx >> 3, c8 = idx & 7; *(bf16x8*)(Ks + kk * KS + 8 * c8) = kr[i]; *(bf16x8*)(Vs + kk * VR + 8 * c8) = vr[i]; }
        __syncthreads();
        if (item + (int)gridDim.x < 1024) SW_LOAD(item + (int)gridDim.x);
        const int hq = kvh * 8 + w; const float sink2 = sinks[hq] * LOG2E;
        bf16x8 qn[2];
#pragma unroll
        for (int ks = 0; ks < 2; ++ks) qn[ks] = *(const bf16x8*)(proj + (R0 + lc) * LDP + hq * 64 + 32 * ks + 8 * g);
        for (int qc = 0; qc < 8; ++qc) {
            const size_t row = R0 + 16 * qc + lc; const int qrel = 16 * qc + lc, T0 = qc & ~1;
            bf16x8 qf[2];
#pragma unroll
            for (int ks = 0; ks < 2; ++ks) qf[ks] = qn[ks];
            if (qc < 7) {
#pragma unroll
                for (int ks = 0; ks < 2; ++ks) qn[ks] = *(const bf16x8*)(proj + (row + 16) * LDP + hq * 64 + 32 * ks + 8 * g); }
            f32x4 s[10]; float mx = sink2;
#pragma unroll
            for (int h5 = 0; h5 < 2; ++h5) { bf16x8 kf[5][2];
#pragma unroll
                for (int i5 = 0; i5 < 5; ++i5)
#pragma unroll
                    for (int ks = 0; ks < 2; ++ks) kf[i5][ks] = *(const bf16x8*)(Ks + (16 * (T0 + 5 * h5 + i5) + lc) * KS + 32 * ks + 8 * g);
#pragma unroll
                for (int i5 = 0; i5 < 5; ++i5) s[5 * h5 + i5] = (f32x4){0.f, 0.f, 0.f, 0.f};
#pragma unroll
                for (int ks = 0; ks < 2; ++ks)
#pragma unroll
                    for (int i5 = 0; i5 < 5; ++i5) s[5 * h5 + i5] = mfma16(kf[i5][ks], qf[ks], s[5 * h5 + i5]); }
#pragma unroll
            for (int i = 0; i < 10; ++i) {
#pragma unroll
                for (int r = 0; r < 4; ++r) { const int kk = 16 * (T0 + i) + 4 * g + r; const bool ok = (kk > qrel) && (kk <= qrel + 128) && (kk >= kk0);
                    s[i][r] = ok ? s[i][r] : -1e30f; mx = fmaxf(mx, s[i][r]); } }
            mx = fmaxf(mx, __shfl_xor(mx, 16)); mx = fmaxf(mx, __shfl_xor(mx, 32));
            float sum = 0.f;
#pragma unroll
            for (int i = 0; i < 10; ++i)
#pragma unroll
                for (int r = 0; r < 4; ++r) { const float p = __builtin_amdgcn_exp2f(s[i][r] - mx); s[i][r] = p; sum += p; }
            sum += __shfl_xor(sum, 16); sum += __shfl_xor(sum, 32);
            const float inv = __builtin_amdgcn_rcpf(sum + __builtin_amdgcn_exp2f(sink2 - mx));
            f32x4 o[4];
#pragma unroll
            for (int et = 0; et < 4; ++et) o[et] = (f32x4){0.f, 0.f, 0.f, 0.f};
            bf16x4 vf[2][4][2];
#pragma unroll
            for (int et = 0; et < 4; ++et) { const bf16_t* vp = Vs + vtb + 16 * T0 * VR + 16 * et; vf[0][et][0] = vtr(vp); vf[0][et][1] = vtr(vp + 16 * VR); }
#pragma unroll
            for (int ip = 0; ip < 5; ++ip) { u32x4 pw; pw.x = pk2(s[2 * ip][0], s[2 * ip][1]); pw.y = pk2(s[2 * ip][2], s[2 * ip][3]); pw.z = pk2(s[2 * ip + 1][0], s[2 * ip + 1][1]); pw.w = pk2(s[2 * ip + 1][2], s[2 * ip + 1][3]);
                const bf16x8 pb = __builtin_bit_cast(bf16x8, pw);
                if (ip < 4) {
#pragma unroll
                    for (int et = 0; et < 4; ++et) { const bf16_t* vp = Vs + vtb + 16 * (T0 + 2 * ip + 2) * VR + 16 * et; vf[(ip + 1) & 1][et][0] = vtr(vp); vf[(ip + 1) & 1][et][1] = vtr(vp + 16 * VR); } }
#pragma unroll
                for (int et = 0; et < 4; ++et) { const bf16x4 a0 = vf[ip & 1][et][0], a1 = vf[ip & 1][et][1];
                    const bf16x8 a = {a0[0], a0[1], a0[2], a0[3], a1[0], a1[1], a1[2], a1[3]}; o[et] = mfma16(a, pb, o[et]); }
                __builtin_amdgcn_sched_barrier(0); }
#pragma unroll
            for (int et = 0; et < 4; ++et) { u32x2 ov; ov.x = pk2(o[et][0] * inv, o[et][1] * inv); ov.y = pk2(o[et][2] * inv, o[et][3] * inv);
                *(u32x2*)(y + row * DM + hq * 64 + 16 * et + 4 * g) = ov; }
        }
    }
#undef SW_LOAD
}
__device__ __forceinline__ void diff_phase(unsigned char* lds, const bf16_t* proj, bf16_t* y, const float* lamv, const float* normw) {
    constexpr int LDP = 3072, KS = 136, VR = 160, XS = 132;
    bf16_t* Kb = (bf16_t*)lds;
    bf16_t* Vb = Kb + 2 * 64 * KS;
    float* Xs = (float*)lds;
    float* lamp = (float*)(lds + 2 * 64 * KS * 2 + 2 * 64 * VR * 2);
    const int tid = otid(), lane = tid & 63, w = tid >> 6, r = lane & 31, hh = lane >> 5, cm = w >> 2, wq = w & 3;
    const float C2 = 0.125f * LOG2E;
    if (w == 0) { const float p01 = wave_sum(lamv[lane] * lamv[64 + lane]), p23 = wave_sum(lamv[128 + lane] * lamv[192 + lane]); if (lane == 0) lamp[0] = expf(p01) - expf(p23) + LAM_INIT; }
    __syncthreads();
    const float lam = lamp[0];
    bf16x8 rk[2], rv[2]; bool have = false;
    for (int item = blockIdx.x; item < 4096; item += gridDim.x) {
        const int rnd = item >> 8, qb = 31 - 2 * rnd - (((item >> 7) & 1) ^ (rnd & 1)), bh = item & 127, b = bh >> 3, h = bh & 7, NT = 2 * qb + 2;
        const size_t Rb = (size_t)b * SEQ, R0 = Rb + 128 * qb;
        const int kcol = 1024 + h * 128, vcol = 2048 + h * 128, qcol = h * 128 + cm * 64;
        const int itn = item + (int)gridDim.x; const bool has_next = itn < 4096;
        const int bhn = itn & 127;
        const size_t Rbn = (size_t)(bhn >> 3) * SEQ; const int kcoln = 1024 + (bhn & 7) * 128, vcoln = 2048 + (bhn & 7) * 128;
        bf16x8 qf[4];
#pragma unroll
        for (int ks = 0; ks < 4; ++ks) qf[ks] = *(const bf16x8*)(proj + (R0 + 32 * wq + r) * LDP + qcol + 16 * ks + 8 * hh);
        f32x16 O[4];
#pragma unroll
        for (int et = 0; et < 4; ++et)
#pragma unroll
            for (int i = 0; i < 16; ++i) O[et][i] = 0.f;
        float mhat = 0.f, lrun = 0.f;
#define DF_LOADX(Rb_, kc_, vc_, jt_) do { const size_t K0_ = (Rb_) + (size_t)(jt_) * 64; \
            _Pragma("unroll") for (int i_ = 0; i_ < 2; ++i_) { const int idx_ = tid + NTHR * i_; rk[i_] = *(const bf16x8*)(proj + (K0_ + (idx_ >> 4)) * LDP + (kc_) + 8 * (idx_ & 15)); \
                rv[i_] = *(const bf16x8*)(proj + (K0_ + (idx_ >> 4)) * LDP + (vc_) + 8 * (idx_ & 15)); } } while (0)
#define DF_LOAD(jt_) DF_LOADX(Rb, kcol, vcol, jt_)
        if (!have) DF_LOAD(0);
        const int qabs = 128 * qb + 32 * wq + r;
        const int vtb = (4 * (lane >> 5) + ((lane & 15) >> 2)) * VR + 16 * ((lane >> 4) & 1) + 4 * (lane & 3);
        u32x4 pbq[4];
#define DF_VRD(dst_, Vt_, ksp_) do { _Pragma("unroll") for (int et_ = 0; et_ < 4; ++et_) { const bf16_t* vp_ = (Vt_) + vtb + (16 * (ksp_)) * VR + 32 * et_; dst_[et_][0] = vtr(vp_); dst_[et_][1] = vtr(vp_ + 8 * VR); } } while (0)
#define DF_VMM(src_, ksp_) do { const bf16x8 pb_ = __builtin_bit_cast(bf16x8, pbq[ksp_]); \
            _Pragma("unroll") for (int et_ = 0; et_ < 4; ++et_) { const bf16x8 a_ = {src_[et_][0][0], src_[et_][0][1], src_[et_][0][2], src_[et_][0][3], src_[et_][1][0], src_[et_][1][1], src_[et_][1][2], src_[et_][1][3]}; O[et_] = mfma32(a_, pb_, O[et_]); } } while (0)
#define DF_PV(Vt_) do { bf16x4 va_[4][2], vb_[4][2]; \
            DF_VRD(va_, Vt_, 0); __builtin_amdgcn_sched_barrier(0); \
            DF_VRD(vb_, Vt_, 1); DF_VMM(va_, 0); __builtin_amdgcn_sched_barrier(0); \
            DF_VRD(va_, Vt_, 2); DF_VMM(vb_, 1); __builtin_amdgcn_sched_barrier(0); \
            DF_VRD(vb_, Vt_, 3); DF_VMM(va_, 2); __builtin_amdgcn_sched_barrier(0); \
            DF_VMM(vb_, 3); __builtin_amdgcn_sched_barrier(0); } while (0)
#define DF_STORE(b_) do { bf16_t* Kd_ = Kb + (b_) * 64 * KS; bf16_t* Vd_ = Vb + (b_) * 64 * VR; \
            _Pragma("unroll") for (int i_ = 0; i_ < 2; ++i_) { const int idx_ = tid + NTHR * i_; *(bf16x8*)(Kd_ + (idx_ >> 4) * KS + 8 * (idx_ & 15)) = rk[i_]; *(bf16x8*)(Vd_ + (idx_ >> 4) * VR + 8 * (idx_ & 15)) = rv[i_]; } } while (0)
        DF_STORE(0);
        if (NT > 1) DF_LOAD(1);
        __syncthreads();
        for (int jt = 0; jt < NT; ++jt) {
            const bf16_t* Kt = Kb + (jt & 1) * 64 * KS; const bf16_t* Vt = Vb + (jt & 1) * 64 * VR;
            f32x16 s[2];
            { bf16x8 kf[2][4];
#pragma unroll
              for (int kt = 0; kt < 2; ++kt)
#pragma unroll
                for (int ks = 0; ks < 4; ++ks) kf[kt][ks] = *(const bf16x8*)(Kt + (32 * kt + r) * KS + cm * 64 + 16 * ks + 8 * hh);
#pragma unroll
              for (int kt = 0; kt < 2; ++kt)
#pragma unroll
                for (int i = 0; i < 16; ++i) s[kt][i] = -mhat;
              __builtin_amdgcn_sched_barrier(0);
#pragma unroll
              for (int ks = 0; ks < 4; ++ks)
#pragma unroll
                for (int kt = 0; kt < 2; ++kt) s[kt] = mfma32(kf[kt][ks], qf[ks], s[kt]);
            }
            if (jt + 1 < NT) { DF_STORE((jt + 1) & 1);
                if (jt + 2 < NT) DF_LOAD(jt + 2);
                else if (has_next) DF_LOADX(Rbn, kcoln, vcoln, 0); }
            if (jt >= NT - 2) {
#pragma unroll
                for (int kt = 0; kt < 2; ++kt)
#pragma unroll
                    for (int i = 0; i < 16; ++i) { const int key = 64 * jt + 32 * kt + (i & 3) + 8 * (i >> 2) + 4 * hh; if (key > qabs) s[kt][i] = -1e30f; }
            }
            float mx = -1e30f;
#pragma unroll
            for (int kt = 0; kt < 2; ++kt)
#pragma unroll
                for (int i = 0; i < 16; ++i) mx = fmaxf(mx, s[kt][i]);
            mx = fmaxf(mx, __shfl_xor(mx, 32));
            const bool first = (jt == 0);
            if (first || __any(mx > 8.0f)) {
                const float dl = first ? mx : fmaxf(mx, 0.f); mhat += dl;
#pragma unroll
                for (int kt = 0; kt < 2; ++kt)
#pragma unroll
                    for (int i = 0; i < 16; ++i) s[kt][i] -= dl;
                if (!first) { const float f = __builtin_amdgcn_exp2f(-dl); lrun *= f;
#pragma unroll
                    for (int et = 0; et < 4; ++et)
#pragma unroll
                        for (int i = 0; i < 16; ++i) O[et][i] *= f; }
            }
            float sum = 0.f;
#pragma unroll
            for (int kt = 0; kt < 2; ++kt)
#pragma unroll
                for (int i = 0; i < 16; ++i) { const float p = __builtin_amdgcn_exp2f(s[kt][i]); s[kt][i] = p; sum += p; }
            lrun += sum;
#pragma unroll
            for (int kt = 0; kt < 2; ++kt)
#pragma unroll
                for (int sp = 0; sp < 2; ++sp) { u32x4 pw; pw.x = pk2(s[kt][8 * sp + 0], s[kt][8 * sp + 1]); pw.y = pk2(s[kt][8 * sp + 2], s[kt][8 * sp + 3]); pw.z = pk2(s[kt][8 * sp + 4], s[kt][8 * sp + 5]); pw.w = pk2(s[kt][8 * sp + 6], s[kt][8 * sp + 7]);
                    pbq[kt * 2 + sp] = pw; }
            DF_PV(Vt);
            lds_barrier();
        }
#undef DF_PV
#undef DF_VRD
#undef DF_VMM
#undef DF_STORE
#undef DF_LOAD
#undef DF_LOADX
        have = has_next;
        const float ltot = lrun + __shfl_xor(lrun, 32), inv = __builtin_amdgcn_rcpf(ltot);
        if (cm == 1) {
#pragma unroll
            for (int et = 0; et < 4; ++et)
#pragma unroll
                for (int rg = 0; rg < 4; ++rg) { const f32x4 v = {O[et][4 * rg] * inv * lam, O[et][4 * rg + 1] * inv * lam, O[et][4 * rg + 2] * inv * lam, O[et][4 * rg + 3] * inv * lam};
                    *(f32x4*)(Xs + (32 * wq + r) * XS + 32 * et + 8 * rg + 4 * hh) = v; }
        }
        __syncthreads();
        if (cm == 0) {
            float ss = 0.f;
#pragma unroll
            for (int et = 0; et < 4; ++et)
#pragma unroll
                for (int rg = 0; rg < 4; ++rg) { const f32x4 x = *(const f32x4*)(Xs + (32 * wq + r) * XS + 32 * et + 8 * rg + 4 * hh);
#pragma unroll
                    for (int i = 0; i < 4; ++i) { const float v = O[et][4 * rg + i] * inv - x[i]; O[et][4 * rg + i] = v; ss += v * v; } }
            ss += __shfl_xor(ss, 32);
            const float rstd = (1.0f - LAM_INIT) * __builtin_amdgcn_rsqf(ss * (1.0f / 128.0f) + 1e-6f);
#pragma unroll
            for (int et = 0; et < 4; ++et)
#pragma unroll
                for (int rg = 0; rg < 4; ++rg) { const int e = 32 * et + 8 * rg + 4 * hh; const f32x4 nw = *(const f32x4*)(normw + e);
                    u32x2 ov; ov.x = pk2(O[et][4 * rg] * rstd * nw[0], O[et][4 * rg + 1] * rstd * nw[1]); ov.y = pk2(O[et][4 * rg + 2] * rstd * nw[2], O[et][4 * rg + 3] * rstd * nw[3]);
                    *(u32x2*)(y + (R0 + 32 * wq + r) * DM + h * 128 + e) = ov; }
        }
        __syncthreads();
    }
}
struct Args { const void* in[24]; float* out; unsigned char* ws; TDesc td[16]; int ntitems; int pad; };
constexpr size_t MiB = 1u << 20;
constexpr size_t WS_MOD = 1 * MiB;
constexpr size_t WS_ROPE = 4 * MiB;
constexpr size_t WS_W = 8 * MiB;
constexpr size_t WS_H = 112 * MiB;
constexpr size_t WS_Y = 240 * MiB;
constexpr size_t WS_P = 368 * MiB;
constexpr size_t WS_XB = 880 * MiB;
constexpr size_t WS_END = 1008 * MiB;
constexpr int NIN[4] = {3328, 1280, 4096, 3072};
__host__ __device__ constexpr size_t w_in_off(int i) { size_t o = 0; for (int j = 0; j < i; ++j) o += (size_t)NIN[j] * 1024; return o; }
constexpr size_t W_OUT0 = (size_t)(3328 + 1280 + 4096 + 3072) * 1024, W_FI0 = W_OUT0 + 4 * (size_t)1024 * 1024, W_FO0 = W_FI0 + 4 * (size_t)5632 * 1024, W_ENDE = W_FO0 + 4 * (size_t)1024 * 2816;
static_assert(WS_W + W_ENDE * 2 <= WS_H, "weights fit");

#ifndef GEMM_ALIGN
#define GEMM_ALIGN true
#endif
#ifndef GEMM_SP2
#define GEMM_SP2 true
#endif
#ifndef PH_MASK
#define PH_MASK 0xFFFF
#endif
#define PH(b) ((PH_MASK >> (b)) & 1)
#ifndef DUP_MASK
#define DUP_MASK 0
#endif
#ifndef DUP_N
#define DUP_N 1
#endif
#define REP(b) for (int rep_ = 0; rep_ < 1 + DUP_N * ((DUP_MASK >> (b)) & 1); ++rep_)
__global__ void __launch_bounds__(NTHR) fwd_megakernel(Args a) {
    extern __shared__ __attribute__((aligned(16))) unsigned char lds[];
    cg::grid_group grid = cg::this_grid();
    const int tid = otid(), lane = tid & 63, wave = __builtin_amdgcn_readfirstlane(tid >> 6);
    unsigned char* ws = a.ws;
    float* mod = (float*)(ws + WS_MOD); float* rope = (float*)(ws + WS_ROPE);
    bf16_t* wts = (bf16_t*)(ws + WS_W); bf16_t* hbuf = (bf16_t*)(ws + WS_H); bf16_t* ybuf = (bf16_t*)(ws + WS_Y); bf16_t* pbuf = (bf16_t*)(ws + WS_P); bf16_t* xb16 = (bf16_t*)(ws + WS_XB);
    const float* x_in = (const float*)a.in[0]; float* xres = a.out;
    LAS unsigned char* lds3 = (LAS unsigned char*)lds;
    for (int u = tid; u < 64; u += NTHR) ((LAS unsigned*)(lds3 + 131072))[u] = 0u;
    __syncthreads();
    const XcdBarrier xbar = xcd_barrier_post((unsigned*)ws, (volatile LAS unsigned*)(lds3 + 131072 + 32));
#define GSYNC() xcd_barrier(xbar)
    if (PH(0)) REP(0) {
        float* scr = (float*)(lds + wave * 16384);
        const int gw = blockIdx.x * 8 + wave, NGW = gridDim.x * 8;
        for (int it = gw; it < a.ntitems; it += NGW) { int k = 0;
#pragma unroll 1
            for (int j = 1; j < 16; ++j) if (it >= a.td[j].item0) k = j;
            transpose_item(a.td[k], scr, it - a.td[k].item0, lane); }
        __syncthreads();
        ada_phase(lds, (const float*)a.in[1], (const float*)a.in[3], (const float*)a.in[4], mod);
        rope_phase((const int*)a.in[2], rope);
    }
    grid.sync();
    if (PH(1)) ln_pass<false>(x_in, nullptr, nullptr, nullptr, mod, hbuf);
    GSYNC();
#pragma unroll 1
    for (int L = 0; L < 4; ++L) {
        const int nin = L == 0 ? 3328 : L == 1 ? 1280 : L == 2 ? 4096 : 3072;
        const size_t wio = L == 0 ? w_in_off(0) : L == 1 ? w_in_off(1) : L == 2 ? w_in_off(2) : w_in_off(3);
        const float* mod0 = mod + (size_t)(2 * L) * 16 * 3072; const float* mod1 = mod0 + 16 * 3072;
        if (PH(2)) { pg8::Gemm g{hbuf, wts + wio, M_TOK, nin, 1024}; pg8::StaticOrder S; S.init(M_TOK, nin, gridDim.x, blockIdx.x);
          pg8::EpiProj E{pbuf, nin, L == 1 ? 1152 : L == 3 ? 2048 : 0, rope, (L == 3 || L == 1) ? 1024 : 0, 0.125f * LOG2E};
          REP(2) pg8::gemm_phase<pg8::EpiProj, pg8::StaticOrder, GEMM_ALIGN, GEMM_SP2>(lds3, g, S, E); }
        GSYNC();
        if (L == 0) { if (PH(3)) { REP(3) linattn_phase<0>(lds, pbuf, 3328, hbuf, (const float*)a.in[8]); GSYNC(); REP(12) linattn_post<0>(hbuf, pbuf, 3328, (const float*)a.in[9], ybuf); } }
        else if (L == 1) { if (PH(4)) REP(4) swa_phase(lds, pbuf, ybuf, (const float*)a.in[12]); }
        else if (L == 2) { if (PH(5)) { REP(5) linattn_phase<1>(lds, pbuf, 4096, hbuf, (const float*)a.in[15]); GSYNC(); REP(12) linattn_post<1>(hbuf, pbuf, 4096, (const float*)a.in[16], ybuf); } }
        else if (PH(6)) { REP(6) diff_phase(lds, pbuf, ybuf, (const float*)a.in[19], (const float*)a.in[20]); }
        GSYNC();
        if (PH(7)) { pg8::Gemm g{ybuf, wts + W_OUT0 + (size_t)L * 1024 * 1024, M_TOK, 1024, 1024}; pg8::StaticOrder S; S.init(M_TOK, 1024, gridDim.x, blockIdx.x);
          pg8::EpiProj E{hbuf, 1024, 0, rope, 0, 1.0f};
          REP(7) pg8::gemm_phase<pg8::EpiProj, pg8::StaticOrder, GEMM_ALIGN, GEMM_SP2>(lds3, g, S, E); }
        GSYNC();
        if (L == 0) resid_ln_pass<true, true>(x_in, xres, mod0 + 2048, (const float*)a.in[5] + (2 * L) * 1024, (const float*)a.in[6] + (2 * L) * 1024, mod1, hbuf, hbuf);
        else resid_ln_pass<true, true>(xres, xres, mod0 + 2048, (const float*)a.in[5] + (2 * L) * 1024, (const float*)a.in[6] + (2 * L) * 1024, mod1, hbuf, hbuf);
        GSYNC();
        if (PH(9)) { pg8::Gemm g{hbuf, wts + W_FI0 + (size_t)L * 5632 * 1024, M_TOK, 5632, 1024}; pg8::StaticOrder S; S.init(M_TOK, 5632, gridDim.x, blockIdx.x);
          pg8::EpiSwiGLU E{pbuf, FFH};
          REP(9) pg8::gemm_phase<pg8::EpiSwiGLU, pg8::StaticOrder, GEMM_ALIGN, GEMM_SP2>(lds3, g, S, E); }
        GSYNC();
        if (PH(10)) { pg8::Gemm g{pbuf, wts + W_FO0 + (size_t)L * 1024 * 2816, M_TOK, 1024, FFH}; pg8::StaticOrder S; S.init(M_TOK, 1024, gridDim.x, blockIdx.x);
          pg8::EpiProj E{hbuf, 1024, 0, rope, 0, 1.0f};
          REP(7) pg8::gemm_phase<pg8::EpiProj, pg8::StaticOrder, GEMM_ALIGN, GEMM_SP2>(lds3, g, S, E); }
        GSYNC();
        if (L < 3) resid_ln_pass<true, true>(xres, xres, mod1 + 2048, (const float*)a.in[5] + (2 * L + 1) * 1024, (const float*)a.in[6] + (2 * L + 1) * 1024, mod1 + 16 * 3072, hbuf, hbuf);
        else resid_ln_pass<true, true>(xres, xres, mod1 + 2048, (const float*)a.in[5] + (2 * L + 1) * 1024, (const float*)a.in[6] + (2 * L + 1) * 1024, nullptr, hbuf, hbuf);
        if (L < 3) GSYNC();
        if ((DUP_MASK >> 13) & 1) { for (int q_ = 0; q_ < 8; ++q_) GSYNC(); }
    }
}

extern "C" void kernel_launch(void* const* d_in, const int* in_sizes, int n_in, void* d_out, int out_size, void* d_ws, size_t ws_size, hipStream_t stream) {
    static int grid = 0;
    if (grid == 0) {
        if (n_in != 24 || out_size != M_TOK * DM || ws_size < WS_END) { fprintf(stderr, "kernel_launch: unexpected shapes (n_in %d out %d ws %zu)\n", n_in, out_size, ws_size); grid = -1; return; }
        int dev = 0, cus = 0, per_cu = 0;
        hipGetDevice(&dev); hipDeviceGetAttribute(&cus, hipDeviceAttributeMultiprocessorCount, dev);
        hipFuncSetAttribute((const void*)fwd_megakernel, hipFuncAttributeMaxDynamicSharedMemorySize, LDS_BYTES);
        hipOccupancyMaxActiveBlocksPerMultiprocessor(&per_cu, (const void*)fwd_megakernel, NTHR, LDS_BYTES);
        (void)hipGetLastError();
        if (per_cu < 1) per_cu = 1;
        grid = cus * per_cu;
        fprintf(stderr, "kernel_launch: cus %d per_cu %d grid %d\n", cus, per_cu, grid);
    }
    if (grid < 0) return;
    if (hipMemsetAsync(d_ws, 0, 16384, stream) != hipSuccess) { fprintf(stderr, "memset failed\n"); return; }
    Args a{};
    for (int i = 0; i < 24; ++i) a.in[i] = d_in[i];
    a.out = (float*)d_out; a.ws = (unsigned char*)d_ws;
    bf16_t* wts = (bf16_t*)((unsigned char*)d_ws + WS_W);
    int nt = 0, k = 0;
    auto add = [&](const float* src, bf16_t* dst, int K, int Nsrc, int Ndst, int mode, int p0) { a.td[k] = TDesc{src, dst, K, Nsrc, Ndst, mode, p0, nt}; nt += (K / 64) * (Ndst / 32); ++k; };
    const int inidx[4] = {7, 11, 14, 18}, outidx[4] = {10, 13, 17, 21}, nsrc[4] = {3080, 1280, 4096, 3072}, ropec[4] = {0, 1152, 0, 2048};
    for (int L = 0; L < 4; ++L) add((const float*)d_in[inidx[L]], wts + w_in_off(L), 1024, nsrc[L], NIN[L], ropec[L] ? 1 : 0, ropec[L]);
    for (int L = 0; L < 4; ++L) add((const float*)d_in[outidx[L]], wts + W_OUT0 + (size_t)L * 1024 * 1024, 1024, 1024, 1024, 0, 0);
    for (int L = 0; L < 4; ++L) add((const float*)d_in[22] + (size_t)L * 1024 * 5632, wts + W_FI0 + (size_t)L * 5632 * 1024, 1024, 5632, 5632, 2, 0);
    for (int L = 0; L < 4; ++L) add((const float*)d_in[23] + (size_t)L * 2816 * 1024, wts + W_FO0 + (size_t)L * 1024 * 2816, 2816, 1024, 1024, 0, 0);
    a.ntitems = nt;
    void* args[] = {&a};
    hipError_t e = hipLaunchCooperativeKernel((const void*)fwd_megakernel, dim3(grid), dim3(NTHR), args, LDS_BYTES, stream);
    if (e != hipSuccess) fprintf(stderr, "cooperative launch failed: %s (grid %d)\n", hipGetErrorString(e), grid);
}
```
